# Optimizing an MI355X kernel written in HIP

```python
import jax, jax.numpy as jnp
from jax import lax
import numpy as np

D_MODEL = 1024
BATCH = 16
SEQ = 4096
DEPTH = 1

CHUNK = 64
D_MIX = D_MODEL
SB_WIDTH = D_MIX // 2
SB_HEADS = 8
SB_HEAD_DIM = SB_WIDTH // SB_HEADS
SB_QBLOCK = 128
ML_WIDTH = D_MIX - SB_WIDTH
ML_HEADS = 4
ML_HEAD_DIM = ML_WIDTH // ML_HEADS
CONV_K = 4
N_IN = 4 * SB_WIDTH + 5 * ML_WIDTH + 2 * ML_HEADS
EPS = 1e-6
GATE_SCALE = 0.1

kernel_name = "hymba_stickbreaking_mlstm_block"


def rms_norm(x, g):
    xf = x.astype(jnp.float32)
    y = xf * lax.rsqrt(jnp.mean(xf * xf, axis=-1, keepdims=True) + EPS)
    return (y * g.astype(jnp.float32)).astype(x.dtype)


def head_layer_norm(h, g):
    mu = jnp.mean(h, axis=-1, keepdims=True)
    hc = h - mu
    var = jnp.mean(hc * hc, axis=-1, keepdims=True)
    y = hc * lax.rsqrt(var + EPS)
    return y * g.astype(jnp.float32).reshape(h.shape[2], h.shape[3])


def causal_depthwise_conv(u, w, b):
    k = w.shape[0]
    y = lax.conv_general_dilated(
        u, w[:, None, :].astype(u.dtype), window_strides=(1,), padding=[(k - 1, 0)],
        dimension_numbers=("NWC", "WIO", "NWC"), feature_group_count=u.shape[-1])
    return y + b.astype(u.dtype)


def stick_breaking_attention(q, k, v):
    s_len, d = q.shape[2], q.shape[3]
    scale = d ** -0.5
    qf, kf, vf = q.astype(jnp.float32), k.astype(jnp.float32), v.astype(jnp.float32)
    outs = []
    for blk in range(s_len // SB_QBLOCK):
        q0 = blk * SB_QBLOCK
        kl = q0 + SB_QBLOCK
        qb = qf[:, :, q0:kl]
        kc = kf[:, :, :kl]
        vc = vf[:, :, :kl]
        z = jnp.einsum("bhqd,bhkd->bhqk", qb, kc) * scale
        qpos = q0 + jnp.arange(SB_QBLOCK)
        kpos = jnp.arange(kl)
        strict = kpos[None, :] < qpos[:, None]
        log_one_minus = jnp.where(strict, jax.nn.log_sigmoid(-z), 0.0)
        suffix = lax.cumsum(log_one_minus, axis=3, reverse=True) - log_one_minus
        a = jnp.where(strict, jnp.exp(jax.nn.log_sigmoid(z) + suffix), 0.0)
        outs.append(jnp.einsum("bhqk,bhkd->bhqd", a, vc))
    return jnp.concatenate(outs, axis=2)


def mlstm_chunkwise(q, k, v, i_pre, f_pre):
    bsz, s_len, nh, dk = q.shape
    dv = v.shape[-1]
    nc = s_len // CHUNK

    def to_chunks(t):
        return t.reshape(bsz, nc, CHUNK, nh, -1).transpose(0, 3, 1, 2, 4)

    def gate_chunks(t):
        return t.reshape(bsz, nc, CHUNK, nh).transpose(0, 3, 1, 2)

    qc = to_chunks(q)
    kc = to_chunks(k * (dk ** -0.5))
    vc = to_chunks(v)
    ig = gate_chunks(i_pre)
    logf = jax.nn.log_sigmoid(gate_chunks(f_pre))
    b = jnp.cumsum(logf, axis=-1)
    g = b[..., -1]
    logw = g[..., None] - b + ig

    def step(carry, xs):
        c_st, n_st, m_st = carry
        k_c, v_c, logw_c, g_c = xs
        m_new = jnp.maximum(g_c + m_st, jnp.max(logw_c, axis=-1))
        w = jnp.exp(logw_c - m_new[..., None])
        decay = jnp.exp(g_c + m_st - m_new)
        c_new = decay[..., None, None] * c_st + jnp.einsum("bhl,bhlk,bhlv->bhkv", w, k_c, v_c)
        n_new = decay[..., None] * n_st + jnp.einsum("bhl,bhlk->bhk", w, k_c)
        return (c_new, n_new, m_new), (c_st, n_st, m_st)

    init = (jnp.zeros((bsz, nh, dk, dv), jnp.float32),
            jnp.zeros((bsz, nh, dk), jnp.float32),
            jnp.zeros((bsz, nh), jnp.float32))
    xs = (kc.transpose(2, 0, 1, 3, 4), vc.transpose(2, 0, 1, 3, 4),
          logw.transpose(2, 0, 1, 3), g.transpose(2, 0, 1))
    _, (c_all, n_all, m_all) = lax.scan(step, init, xs)
    c_all = c_all.transpose(1, 2, 0, 3, 4)
    n_all = n_all.transpose(1, 2, 0, 3)
    m_all = m_all.transpose(1, 2, 0)

    causal = jnp.tril(jnp.ones((CHUNK, CHUNK), dtype=bool))
    dmat = b[..., :, None] - b[..., None, :] + ig[..., None, :]
    dmat = jnp.where(causal, dmat, -jnp.inf)
    m_inter = b + m_all[..., None]
    m_out = jnp.maximum(m_inter, jnp.max(dmat, axis=-1))
    scores = jnp.einsum("bhcld,bhcsd->bhcls", qc, kc) * jnp.exp(dmat - m_out[..., None])
    inter_w = jnp.exp(m_inter - m_out)
    num = (inter_w[..., None] * jnp.einsum("bhcld,bhcdv->bhclv", qc, c_all)
           + jnp.einsum("bhcls,bhcsv->bhclv", scores, vc))
    den = inter_w * jnp.einsum("bhcld,bhcd->bhcl", qc, n_all) + jnp.sum(scores, axis=-1)
    h = num / jnp.maximum(jnp.abs(den), jnp.exp(-m_out))[..., None]
    return h.transpose(0, 2, 3, 1, 4).reshape(bsz, s_len, nh, dv)


def setup_inputs(seed: int = 0) -> dict:
    key = jax.random.key(seed)
    ks = jax.random.split(key, 12)
    x = jax.random.normal(ks[0], (BATCH, SEQ, D_MODEL), jnp.float32)
    norm_g = 1.0 + 0.01 * jax.random.normal(ks[1], (DEPTH, D_MODEL), jnp.float32)
    col_scale = jnp.concatenate([jnp.ones((N_IN - 2 * ML_HEADS,), jnp.float32),
                                 jnp.full((2 * ML_HEADS,), GATE_SCALE, jnp.float32)])
    w_in = jax.random.normal(ks[2], (DEPTH, D_MODEL, N_IN), jnp.float32) * (D_MODEL ** -0.5) * col_scale
    b_igate = 0.1 * jax.random.normal(ks[3], (DEPTH, ML_HEADS), jnp.float32)
    b_fgate = (jnp.linspace(3.0, 6.0, ML_HEADS, dtype=jnp.float32)[None, :]
               + 0.01 * jax.random.normal(ks[4], (DEPTH, ML_HEADS), jnp.float32))
    conv_w = jax.random.normal(ks[5], (DEPTH, CONV_K, 2 * ML_WIDTH), jnp.float32) * (CONV_K ** -0.5)
    conv_b = 0.01 * jax.random.normal(ks[6], (DEPTH, 2 * ML_WIDTH), jnp.float32)
    head_norm_g = 1.0 + 0.01 * jax.random.normal(ks[7], (DEPTH, ML_WIDTH), jnp.float32)
    w_out = jax.random.normal(ks[8], (DEPTH, D_MIX, D_MODEL), jnp.float32) * (D_MIX ** -0.5)
    final_norm_g = 1.0 + 0.01 * jax.random.normal(ks[9], (D_MODEL,), jnp.float32)
    return {"x": x, "norm_g": norm_g, "w_in": w_in, "b_igate": b_igate, "b_fgate": b_fgate,
            "conv_w": conv_w, "conv_b": conv_b, "head_norm_g": head_norm_g,
            "w_out": w_out, "final_norm_g": final_norm_g}


def reference(x, norm_g, w_in, b_igate, b_fgate, conv_w, conv_b, head_norm_g, w_out, final_norm_g):
    bsz, s_len, _ = x.shape
    sizes = [SB_WIDTH] * 4 + [ML_WIDTH] * 5 + [ML_HEADS, ML_HEADS]
    split_at = [int(v) for v in np.cumsum(sizes)[:-1]]
    h = x
    for layer in range(DEPTH):
        u = rms_norm(h, norm_g[layer])
        p = u @ w_in[layer].astype(u.dtype)
        (sb_q, sb_k, sb_v, sb_z, m_q, m_k, m_v, m_o, m_z, m_i, m_f) = jnp.split(p, split_at, axis=-1)

        def sb_heads(t):
            return t.reshape(bsz, s_len, SB_HEADS, SB_HEAD_DIM).transpose(0, 2, 1, 3)
        sb = stick_breaking_attention(sb_heads(sb_q), sb_heads(sb_k), sb_heads(sb_v))
        sb = sb.transpose(0, 2, 1, 3).reshape(bsz, s_len, SB_WIDTH).astype(x.dtype)
        sb_out = sb * jax.nn.silu(sb_z)

        qk = causal_depthwise_conv(jnp.concatenate([m_q, m_k], axis=-1), conv_w[layer], conv_b[layer])
        mq, mk = jnp.split(qk, 2, axis=-1)

        def ml_heads(t):
            return t.reshape(bsz, s_len, ML_HEADS, ML_HEAD_DIM).astype(jnp.float32)
        i_pre = (m_i + b_igate[layer].astype(m_i.dtype)).astype(jnp.float32)
        f_pre = (m_f + b_fgate[layer].astype(m_f.dtype)).astype(jnp.float32)
        hm = mlstm_chunkwise(ml_heads(mq), ml_heads(mk), ml_heads(m_v), i_pre, f_pre)
        hm = hm * jax.nn.sigmoid(ml_heads(m_o))
        hm = head_layer_norm(hm, head_norm_g[layer])
        ml_out = hm.reshape(bsz, s_len, ML_WIDTH).astype(x.dtype) * jax.nn.silu(m_z)

        mix = jnp.concatenate([sb_out, ml_out], axis=-1)
        h = h + mix @ w_out[layer].astype(mix.dtype)
    return rms_norm(h, final_norm_g)
```

```cpp
#include <hip/hip_runtime.h>
#include <hip/hip_cooperative_groups.h>
#include <cstdio>
namespace cg = cooperative_groups;

#ifndef FAST_ATT
#define FAST_ATT 0
#endif
#ifndef FAST_ML
#define FAST_ML 0
#endif

#define LAS __attribute__((address_space(3)))
typedef unsigned short bf16_t;
typedef short bf16x8 __attribute__((ext_vector_type(8)));
typedef short s16x4 __attribute__((ext_vector_type(4)));
typedef float f32x4 __attribute__((ext_vector_type(4)));
typedef unsigned u32x4 __attribute__((ext_vector_type(4)));
typedef unsigned u32x2 __attribute__((ext_vector_type(2)));

constexpr int NTOK = 65536, DM = 1024, SEQ = 4096, NP = 4608, NIN = 4616;
constexpr int LDS_BYTES = 131072;
constexpr float EPS = 1e-6f;
constexpr float LOG2E = 1.4426950408889634f, LN2 = 0.6931471805599453f;

struct Params {
    const float *x, *norm_g, *w_in, *b_ig, *b_fg, *conv_w, *conv_b, *hn_g, *w_out, *fin_g;
    float* out;
    bf16_t *U, *P, *MIX, *WIT, *WOT;
    float *G, *MLG, *ROWSS, *HRAW;
};

__device__ __forceinline__ float bf2f(bf16_t b) { return __uint_as_float(((unsigned)b) << 16); }
__device__ __forceinline__ float bflo(unsigned w) { return __uint_as_float(w << 16); }
__device__ __forceinline__ float bfhi(unsigned w) { return __uint_as_float(w & 0xffff0000u); }
__device__ __forceinline__ unsigned cvt_pk_bf16(float lo, float hi) { unsigned r; asm volatile("v_cvt_pk_bf16_f32 %0, %1, %2" : "=v"(r) : "v"(lo), "v"(hi)); return r; }
__device__ __forceinline__ bf16_t f2bf(float f) { return (bf16_t)(cvt_pk_bf16(f, 0.f) & 0xffffu); }
__device__ __forceinline__ float wave_sum(float v) {
#pragma unroll
    for (int o = 1; o < 64; o <<= 1) v += __shfl_xor(v, o);
    return v;
}
__device__ __forceinline__ float sigmoidf_(float z) { return 1.f / (1.f + __expf(-z)); }

namespace pg8 {
constexpr int BM = 256, BK = 64, HALF = 128, HTB = HALF * BK * 2, NXCD = 8, WGM = 8;
__device__ __forceinline__ int lds_byte(int r, int c) { const int st = (r >> 4) * 2 + (c >> 5), rr = r & 15, cc = c & 31, ob = rr * 64 + cc * 2; return st * 1024 + (ob ^ (((ob >> 9) & 1) << 5)); }
__device__ __forceinline__ void stage_rc(int b, int& R, int& C) { const int st = b / 1024, sb = b % 1024, swz = sb ^ (((sb >> 9) & 1) << 5); R = (st >> 1) * 16 + swz / 64; C = (st & 1) * 32 + (swz % 64) / 2; }
__device__ __forceinline__ int perm32(int rho) { const int n = rho >> 4, i = rho & 15; return 8 * (i >> 2) + 4 * n + (i & 3); }
struct Unit { int pm, pn; };
struct Gemm { const bf16_t* A; const bf16_t* Bt; int M, N, K; };
struct StaticOrder {
    int nM, nN, nwg, G, c;
    __device__ void init(int M, int N, int G_, int c_) { nM = M / BM; nN = N / BM; nwg = nM * nN; G = G_; c = c_; }
    __device__ bool next(int i, Unit& u) const {
        const long L = (long)i * G + c; if (L >= nwg) return false;
        int wgid = (int)L; { const int q = nwg / NXCD, r = nwg % NXCD, xcd = wgid % NXCD, off = wgid / NXCD; wgid = (xcd < r ? xcd * (q + 1) : r * (q + 1) + (xcd - r) * q) + off; }
        const int nig = WGM * nN, gid = wgid / nig, fm = gid * WGM, gsz = (nM - fm) < WGM ? (nM - fm) : WGM;
        u.pm = fm + ((wgid % nig) % gsz); u.pn = (wgid % nig) / gsz; return true;
    }
};
struct EpiBf16 {
    static constexpr bool PERM = true;
    bf16_t* O; int ldc;
    __device__ __forceinline__ void operator()(const f32x4 (&acc)[2][2][4][2], const Unit& u, int wr, int wc, int fr, int fq) const {
        const int row0 = u.pm * BM + wr * 64 + fr; const int col0 = u.pn * BM + wc * 32 + 8 * fq;
#pragma unroll
        for (int ai = 0; ai < 2; ++ai)
#pragma unroll
            for (int m = 0; m < 4; ++m) { bf16_t* rowp = O + (size_t)(row0 + ai * HALF + m * 16) * ldc + col0;
#pragma unroll
                for (int bj = 0; bj < 2; ++bj) { const f32x4 v0 = acc[ai][bj][m][0], v1 = acc[ai][bj][m][1];
                    u32x4 w; w.x = cvt_pk_bf16(v0[0], v0[1]); w.y = cvt_pk_bf16(v0[2], v0[3]); w.z = cvt_pk_bf16(v1[0], v1[1]); w.w = cvt_pk_bf16(v1[2], v1[3]);
                    *(u32x4*)(rowp + bj * HALF) = w; } }
    }
};
struct EpiOut {
    static constexpr bool PERM = false;
    float* C; const float* X; float* rowss;
    __device__ __forceinline__ void operator()(const f32x4 (&acc)[2][2][4][2], const Unit& u, int wr, int wc, int fr, int fq) const {
        const int row0 = u.pm * BM + wr * 64 + fr, col0 = u.pn * BM + wc * 32 + 4 * fq;
#pragma unroll
        for (int ai = 0; ai < 2; ++ai)
#pragma unroll
            for (int m = 0; m < 4; ++m) { const int row = row0 + ai * HALF + m * 16; float* rowp = C + (size_t)row * DM + col0; const float* xp = X + (size_t)row * DM + col0; float ss = 0.f;
#pragma unroll
                for (int bj = 0; bj < 2; ++bj)
#pragma unroll
                    for (int n = 0; n < 2; ++n) { const f32x4 xv = *(const f32x4*)(xp + bj * HALF + n * 16); const f32x4 hv = xv + acc[ai][bj][m][n];
                        *(f32x4*)(rowp + bj * HALF + n * 16) = hv; ss += (hv[0] * hv[0] + hv[1] * hv[1]) + (hv[2] * hv[2] + hv[3] * hv[3]); }
                ss += __shfl_xor(ss, 16); ss += __shfl_xor(ss, 32);
                if (fq == 0) atomicAdd(rowss + row, ss); }
    }
};

template <class Epi>
__device__ __forceinline__ void gemm_phase(LAS unsigned char* lds, const Gemm g, const StaticOrder& S, const Epi& E) {
    const int tid = threadIdx.x, wid = __builtin_amdgcn_readfirstlane(tid >> 6), lane = tid & 63, wr = wid >> 2, wc = wid & 3, fr = lane & 15, fq = lane >> 4;
    const int K = g.K, nt = K / BK;
    unsigned voffA[2], voffB[2];
#pragma unroll
    for (int i = 0; i < 2; ++i) { int R, C; stage_rc(tid * 16 + i * 8192, R, C); const int Rb = Epi::PERM ? ((R & ~31) + perm32(R & 31)) : R;
        voffA[i] = (unsigned)(R * K + C) * 2u; voffB[i] = (unsigned)(Rb * K + C) * 2u; }
    const size_t kstep = (size_t)(BK * 2);
    const size_t hstep = (size_t)HALF * K * 2;
    const size_t tstep = 2 * hstep;
    const unsigned ldsw = (unsigned)wid * 1024u;
    const int aoff = lds_byte(wr * 64 + fr, fq * 8), boff = lds_byte(wc * 32 + fr, fq * 8);
#define PG8_SA(b, h) (((b) * 2 + (h)) * HTB)
#define PG8_SB(b, h) ((4 + (b) * 2 + (h)) * HTB)
#define PG8_STAGE(bufoff, gbase, voff) do { _Pragma("unroll") for (int _i = 0; _i < 2; ++_i) \
        __builtin_amdgcn_global_load_lds((const unsigned*)((const char*)(gbase) + (voff)[_i]), (LAS unsigned*)(lds + (bufoff) + ldsw + _i * 8192), 16, 0, 0); } while (0)
#define PG8_LDA(dst, b, h) do { _Pragma("unroll") for (int m = 0; m < 4; ++m) _Pragma("unroll") for (int k = 0; k < 2; ++k) dst[m][k] = *(const LAS bf16x8*)(lds + PG8_SA(b, h) + aoff + m * 2048 + k * 1024); } while (0)
#define PG8_LDB(dst, b, h) do { _Pragma("unroll") for (int n = 0; n < 2; ++n) _Pragma("unroll") for (int k = 0; k < 2; ++k) dst[n][k] = *(const LAS bf16x8*)(lds + PG8_SB(b, h) + boff + n * 2048 + k * 1024); } while (0)
#define PG8_MMA(ai, bj, At, Bt) do { __builtin_amdgcn_s_setprio(1); _Pragma("unroll") for (int m = 0; m < 4; ++m) _Pragma("unroll") for (int n = 0; n < 2; ++n) _Pragma("unroll") for (int k = 0; k < 2; ++k) \
        acc[ai][bj][m][n] = __builtin_amdgcn_mfma_f32_16x16x32_bf16(Bt[n][k], At[m][k], acc[ai][bj][m][n], 0, 0, 0); __builtin_amdgcn_s_setprio(0); } while (0)
#define PG8_WAIT_V(n) asm volatile("s_waitcnt vmcnt(" #n ")" ::: "memory")
#define PG8_WAIT_L(n) asm volatile("s_waitcnt lgkmcnt(" #n ")" ::: "memory")
#define PG8_BAR __builtin_amdgcn_s_barrier()
#define PG8_SCHED __builtin_amdgcn_sched_barrier(0)
    Unit cur, nxt; int ui = 0;
    if (!S.next(0, cur)) return;
    f32x4 acc[2][2][4][2];
#pragma unroll
    for (int a = 0; a < 2; ++a)
#pragma unroll
        for (int b = 0; b < 2; ++b)
#pragma unroll
            for (int m = 0; m < 4; ++m)
#pragma unroll
                for (int n = 0; n < 2; ++n) acc[a][b][m][n] = (f32x4){0.f, 0.f, 0.f, 0.f};
    bf16x8 At[4][2], B0[2][2], B1[2][2];
    const char* cA = (const char*)g.A + (size_t)cur.pm * tstep; const char* cB = (const char*)g.Bt + (size_t)cur.pn * tstep;
    PG8_STAGE(PG8_SB(0, 0), cB, voffB); PG8_STAGE(PG8_SA(0, 0), cA, voffA); PG8_STAGE(PG8_SB(0, 1), cB + hstep, voffB); PG8_STAGE(PG8_SA(0, 1), cA + hstep, voffA);
    if (wr == 1) PG8_BAR;
    PG8_WAIT_V(4); PG8_BAR;
    PG8_STAGE(PG8_SB(1, 0), cB + kstep, voffB); PG8_STAGE(PG8_SA(1, 0), cA + kstep, voffA); PG8_STAGE(PG8_SB(1, 1), cB + hstep + kstep, voffB);
    PG8_WAIT_V(6); PG8_BAR;
    for (;;) {
        const bool has_next = S.next(ui + 1, nxt);
        const char* nA = has_next ? (const char*)g.A + (size_t)nxt.pm * tstep : cA; const char* nB = has_next ? (const char*)g.Bt + (size_t)nxt.pn * tstep : cB;
        for (int t = 0; t < nt; t += 2) {
            const bool last = (t == nt - 2);
            const char* a1 = cA + (size_t)(t + 1) * kstep;
            const char* a2 = last ? nA : cA + (size_t)(t + 2) * kstep; const char* b2 = last ? nB : cB + (size_t)(t + 2) * kstep;
            const char* a3 = a2 + kstep; const char* b3 = b2 + kstep;
            PG8_LDB(B0, 0, 0); PG8_SCHED; PG8_LDA(At, 0, 0); PG8_STAGE(PG8_SA(1, 1), a1 + hstep, voffA);
            PG8_WAIT_L(8); PG8_BAR; PG8_WAIT_L(0); PG8_MMA(0, 0, At, B0); PG8_BAR; PG8_SCHED;
            PG8_LDB(B1, 0, 1); PG8_STAGE(PG8_SB(0, 0), b2, voffB);
            PG8_BAR; PG8_WAIT_L(0); PG8_MMA(0, 1, At, B1); PG8_BAR;
            PG8_LDA(At, 0, 1); PG8_STAGE(PG8_SA(0, 0), a2, voffA);
            PG8_BAR; PG8_WAIT_L(0); PG8_MMA(1, 0, At, B0); PG8_BAR; PG8_SCHED;
            PG8_STAGE(PG8_SB(0, 1), b2 + hstep, voffB);
            PG8_WAIT_V(6); PG8_BAR; PG8_MMA(1, 1, At, B1); PG8_BAR;
            PG8_LDB(B0, 1, 0); PG8_SCHED; PG8_LDA(At, 1, 0); PG8_STAGE(PG8_SA(0, 1), a2 + hstep, voffA);
            PG8_WAIT_L(8); PG8_BAR; PG8_WAIT_L(0); PG8_MMA(0, 0, At, B0); PG8_BAR; PG8_SCHED;
            PG8_LDB(B1, 1, 1); PG8_STAGE(PG8_SB(1, 0), b3, voffB);
            PG8_BAR; PG8_WAIT_L(0); PG8_MMA(0, 1, At, B1); PG8_BAR;
            PG8_LDA(At, 1, 1); PG8_STAGE(PG8_SA(1, 0), a3, voffA);
            PG8_BAR; PG8_WAIT_L(0); PG8_MMA(1, 0, At, B0); PG8_BAR; PG8_SCHED;
            PG8_STAGE(PG8_SB(1, 1), b3 + hstep, voffB);
            PG8_WAIT_V(6); PG8_BAR; PG8_MMA(1, 1, At, B1); PG8_BAR;
        }
        E(acc, cur, wr, wc, fr, fq);
        if (!has_next) break;
#pragma unroll
        for (int a = 0; a < 2; ++a)
#pragma unroll
            for (int b = 0; b < 2; ++b)
#pragma unroll
                for (int m = 0; m < 4; ++m)
#pragma unroll
                    for (int n = 0; n < 2; ++n) acc[a][b][m][n] = (f32x4){0.f, 0.f, 0.f, 0.f};
        cur = nxt; cA = nA; cB = nB; ++ui;
    }
    PG8_WAIT_V(0);
    if (wr == 0) PG8_BAR;
    PG8_BAR;
#undef PG8_SA
#undef PG8_SB
#undef PG8_STAGE
#undef PG8_LDA
#undef PG8_LDB
#undef PG8_MMA
#undef PG8_WAIT_V
#undef PG8_WAIT_L
#undef PG8_BAR
#undef PG8_SCHED
}
}

__device__ __forceinline__ void phase_prep(const Params& p) {
    const int tid = threadIdx.x, lane = tid & 63, wid = tid >> 6;
    const int gt = blockIdx.x * 512 + tid, NGT = gridDim.x * 512;
    for (int i = gt; i < NTOK; i += NGT) p.ROWSS[i] = 0.f;
    for (int it = gt; it < NP * 128; it += NGT) {
        const int n = it % NP, k8 = it / NP; const float sc = n < 512 ? 0.125f : 1.0f;
        float v[8];
#pragma unroll
        for (int j = 0; j < 8; ++j) v[j] = p.w_in[(size_t)(k8 * 8 + j) * NIN + n] * sc;
        u32x4 w; w.x = cvt_pk_bf16(v[0], v[1]); w.y = cvt_pk_bf16(v[2], v[3]); w.z = cvt_pk_bf16(v[4], v[5]); w.w = cvt_pk_bf16(v[6], v[7]);
        *(u32x4*)(p.WIT + (size_t)n * DM + k8 * 8) = w;
    }
    for (int it = gt; it < DM * 128; it += NGT) {
        const int n = it % DM, k8 = it / DM;
        float v[8];
#pragma unroll
        for (int j = 0; j < 8; ++j) v[j] = p.w_out[(size_t)(k8 * 8 + j) * DM + n];
        u32x4 w; w.x = cvt_pk_bf16(v[0], v[1]); w.y = cvt_pk_bf16(v[2], v[3]); w.z = cvt_pk_bf16(v[4], v[5]); w.w = cvt_pk_bf16(v[6], v[7]);
        *(u32x4*)(p.WOT + (size_t)n * DM + k8 * 8) = w;
    }
    float gk[16], wg[16][8];
#pragma unroll
    for (int j = 0; j < 4; ++j)
#pragma unroll
        for (int e = 0; e < 4; ++e) { const int k = 4 * lane + 256 * j + e; const float g = p.norm_g[k]; gk[j * 4 + e] = g;
#pragma unroll
            for (int c = 0; c < 8; ++c) wg[j * 4 + e][c] = g * p.w_in[(size_t)k * NIN + NP + c]; }
    const float bias = (lane < 4) ? p.b_ig[lane] : (lane < 8 ? p.b_fg[lane - 4] : 0.f);
    const int gw = blockIdx.x * 8 + wid, NGW = gridDim.x * 8;
    f32x4 v[4], vn[4];
    if (gw < NTOK) {
#pragma unroll
        for (int j = 0; j < 4; ++j) v[j] = *(const f32x4*)(p.x + (size_t)gw * DM + 4 * lane + 256 * j);
    }
    for (int row = gw; row < NTOK; row += NGW) {
        const int nrow = row + NGW;
        if (nrow < NTOK) {
#pragma unroll
            for (int j = 0; j < 4; ++j) vn[j] = *(const f32x4*)(p.x + (size_t)nrow * DM + 4 * lane + 256 * j);
        }
        float ss = 0.f;
#pragma unroll
        for (int j = 0; j < 4; ++j) ss += (v[j][0] * v[j][0] + v[j][1] * v[j][1]) + (v[j][2] * v[j][2] + v[j][3] * v[j][3]);
        ss = wave_sum(ss);
        const float rstd = rsqrtf(ss * (1.f / DM) + EPS);
        float gacc[8];
#pragma unroll
        for (int c = 0; c < 8; ++c) gacc[c] = 0.f;
#pragma unroll
        for (int j = 0; j < 4; ++j) {
#pragma unroll
            for (int e = 0; e < 4; ++e) {
#pragma unroll
                for (int c = 0; c < 8; ++c) gacc[c] += v[j][e] * wg[j * 4 + e][c];
            }
            u32x2 w; w.x = cvt_pk_bf16(v[j][0] * rstd * gk[j * 4 + 0], v[j][1] * rstd * gk[j * 4 + 1]); w.y = cvt_pk_bf16(v[j][2] * rstd * gk[j * 4 + 2], v[j][3] * rstd * gk[j * 4 + 3]);
            *(u32x2*)(p.U + (size_t)row * DM + 4 * lane + 256 * j) = w;
        }
        float mine = 0.f;
#pragma unroll
        for (int c = 0; c < 8; ++c) { const float s = wave_sum(gacc[c]); mine = (lane == c) ? s : mine; }
        if (lane < 8) p.G[(size_t)row * 8 + lane] = mine * rstd + bias;
#pragma unroll
        for (int j = 0; j < 4; ++j) v[j] = vn[j];
    }
}

__device__ __forceinline__ float softplus_acc(float z) { return fmaxf(z, 0.f) + log1pf(expf(-fabsf(z))); }

__device__ void att_naive(const Params& p, int nb_first, int nb_count) {
    const int tix = ((int)blockIdx.x - nb_first) * 512 + (int)threadIdx.x, nthr = nb_count * 512;
    for (int idx = tix; idx < 16 * 8 * SEQ; idx += nthr) {
        const int t = idx & (SEQ - 1), h = (idx >> 12) & 7, b = idx >> 15;
        const size_t row = (size_t)b * SEQ + t;
        const bf16_t* qp = p.P + row * NP + h * 64;
        float q[64], acc[64];
#pragma unroll
        for (int c = 0; c < 8; ++c) { const u32x4 w = *(const u32x4*)(qp + 8 * c);
#pragma unroll
            for (int e = 0; e < 4; ++e) { q[8 * c + 2 * e] = bflo(w[e]); q[8 * c + 2 * e + 1] = bfhi(w[e]); } }
#pragma unroll
        for (int d = 0; d < 64; ++d) acc[d] = 0.f;
        float carry = 0.f;
        for (int s = t - 1; s >= 0; --s) {
            const bf16_t* kp = p.P + ((size_t)b * SEQ + s) * NP + 512 + h * 64;
            const bf16_t* vp = kp + 512;
            float z = 0.f;
#pragma unroll
            for (int c = 0; c < 8; ++c) { const u32x4 w = *(const u32x4*)(kp + 8 * c);
#pragma unroll
                for (int e = 0; e < 4; ++e) { z += q[8 * c + 2 * e] * bflo(w[e]); z += q[8 * c + 2 * e + 1] * bfhi(w[e]); } }
            const float sp = softplus_acc(z);
            const float wgt = expf(z - sp + carry);
#pragma unroll
            for (int c = 0; c < 8; ++c) { const u32x4 w = *(const u32x4*)(vp + 8 * c);
#pragma unroll
                for (int e = 0; e < 4; ++e) { acc[8 * c + 2 * e] += wgt * bflo(w[e]); acc[8 * c + 2 * e + 1] += wgt * bfhi(w[e]); } }
            carry -= sp;
            if (carry < -104.f) break;
        }
        const bf16_t* zp = p.P + row * NP + 1536 + h * 64;
        bf16_t* op = p.MIX + row * DM + h * 64;
#pragma unroll
        for (int c = 0; c < 8; ++c) { const u32x4 w = *(const u32x4*)(zp + 8 * c); u32x4 o;
#pragma unroll
            for (int e = 0; e < 4; ++e) { const float z0 = bflo(w[e]), z1 = bfhi(w[e]);
                o[e] = cvt_pk_bf16(acc[8 * c + 2 * e] * z0 * sigmoidf_(z0), acc[8 * c + 2 * e + 1] * z1 * sigmoidf_(z1)); }
            *(u32x4*)(op + 8 * c) = o; }
    }
}

__device__ void ml_naive(const Params& p, LAS unsigned char* lds) {
    const int bh = blockIdx.x; if (bh >= 64) return;
    const int b = bh >> 2, h = bh & 3, tid = threadIdx.x, lane = tid & 63;
    LAS float* qs = (LAS float*)lds; LAS float* ks = qs + 128; LAS float* vs = ks + 128; LAS float* part = vs + 128; LAS float* sc = part + 512; LAS float* qn = sc + 8;
    const int v = tid & 127, kg = tid >> 7;
    float C[32];
#pragma unroll
    for (int i = 0; i < 32; ++i) C[i] = 0.f;
    float nreg = 0.f, m = 0.f;
    float cw[4] = {0.f, 0.f, 0.f, 0.f}, cb = 0.f;
    if (tid < 256) { const int ch = (tid < 128) ? (h * 128 + tid) : (512 + h * 128 + (tid - 128));
#pragma unroll
        for (int j = 0; j < 4; ++j) cw[j] = p.conv_w[j * 1024 + ch];
        cb = p.conv_b[ch]; }
    for (int t = 0; t < SEQ; ++t) {
        const size_t row = (size_t)b * SEQ + t;
        if (tid < 256) {
            const int col = ((tid < 128) ? 2048 : 2560) + h * 128 + (tid & 127);
            float val = cb;
#pragma unroll
            for (int j = 0; j < 4; ++j) { const int tt = t - 3 + j; if (tt >= 0) val += cw[j] * bf2f(p.P[((size_t)b * SEQ + tt) * NP + col]); }
            if (tid < 128) qs[tid] = val; else ks[tid - 128] = val * 0.08838834764831845f;
        } else if (tid < 384) {
            vs[tid - 256] = bf2f(p.P[row * NP + 3072 + h * 128 + (tid - 256)]);
        } else if (tid == 384) {
            const float ig = p.G[row * 8 + h], fg = p.G[row * 8 + 4 + h];
            const float logf = -softplus_acc(-fg);
            const float mn = fmaxf(logf + m, ig);
            sc[0] = expf(ig - mn); sc[1] = expf(logf + m - mn); sc[2] = expf(-mn); m = mn;
        }
        __syncthreads();
        const float ip = sc[0], fp = sc[1];
        const float vv = vs[v]; float pa = 0.f;
#pragma unroll
        for (int i = 0; i < 32; ++i) { C[i] = fp * C[i] + ip * ks[kg * 32 + i] * vv; pa += qs[kg * 32 + i] * C[i]; }
        part[kg * 128 + v] = pa;
        if (tid < 128) { nreg = fp * nreg + ip * ks[tid]; float xq = qs[tid] * nreg; xq = wave_sum(xq); if (lane == 0) qn[tid >> 6] = xq; }
        __syncthreads();
        if (tid < 128) { const float num = (part[v] + part[128 + v]) + (part[256 + v] + part[384 + v]); const float den = qn[0] + qn[1];
            p.HRAW[row * 512 + h * 128 + v] = num / fmaxf(fabsf(den), sc[2]); }
        __syncthreads();
    }
}

__device__ void ml_post_naive(const Params& p) {
    const int tid = threadIdx.x, lane = tid & 63, wid = tid >> 6;
    const int gw = blockIdx.x * 8 + wid, NGW = gridDim.x * 8;
    for (int task = gw; task < NTOK * 4; task += NGW) {
        const size_t row = task >> 2; const int h = task & 3;
        float a[2];
#pragma unroll
        for (int i = 0; i < 2; ++i) { const int c = h * 128 + lane + 64 * i; a[i] = p.HRAW[row * 512 + c] * sigmoidf_(bf2f(p.P[row * NP + 3584 + c])); }
        const float mean = wave_sum(a[0] + a[1]) * (1.f / 128.f);
        const float d0 = a[0] - mean, d1 = a[1] - mean;
        const float var = wave_sum(d0 * d0 + d1 * d1) * (1.f / 128.f);
        const float rstd = rsqrtf(var + EPS);
#pragma unroll
        for (int i = 0; i < 2; ++i) { const int c = h * 128 + lane + 64 * i; const float z = bf2f(p.P[row * NP + 4096 + c]);
            const float y = (a[i] - mean) * rstd * p.hn_g[c] * z * sigmoidf_(z);
            p.MIX[row * DM + 512 + c] = f2bf(y); }
    }
}

__device__ __forceinline__ void phase_final(const Params& p) {
    const int gt = blockIdx.x * 512 + threadIdx.x, NGT = gridDim.x * 512;
    for (int it = gt; it < NTOK * 256; it += NGT) {
        const int row = it >> 8, c4 = (it & 255) * 4;
        const float rstd = rsqrtf(p.ROWSS[row] * (1.f / DM) + EPS);
        f32x4 hv = *(f32x4*)(p.out + (size_t)row * DM + c4); const f32x4 g = *(const f32x4*)(p.fin_g + c4);
        hv = hv * rstd * g;
        *(f32x4*)(p.out + (size_t)row * DM + c4) = hv;
    }
}

__global__ void __launch_bounds__(512, 2) hymba_fwd(Params p) {
    extern __shared__ __attribute__((aligned(16))) unsigned char smem[];
    LAS unsigned char* lds = (LAS unsigned char*)smem;
    cg::grid_group grid = cg::this_grid();
    phase_prep(p);
    grid.sync();
    {
        pg8::Gemm g{p.U, p.WIT, NTOK, NP, DM}; pg8::StaticOrder S; S.init(NTOK, NP, gridDim.x, blockIdx.x);
        pg8::EpiBf16 E{p.P, NP};
        pg8::gemm_phase(lds, g, S, E);
    }
    grid.sync();
    if (blockIdx.x < 64) ml_naive(p, lds);
    else att_naive(p, 64, (int)gridDim.x - 64);
    grid.sync();
    ml_post_naive(p);
    grid.sync();
    {
        pg8::Gemm g{p.MIX, p.WOT, NTOK, DM, DM}; pg8::StaticOrder S; S.init(NTOK, DM, gridDim.x, blockIdx.x);
        pg8::EpiOut E{p.out, p.x, p.ROWSS};
        pg8::gemm_phase(lds, g, S, E);
    }
    grid.sync();
    phase_final(p);
}

extern "C" void kernel_launch(void* const* d_in, const int* in_sizes, int n_in, void* d_out, int out_size, void* d_ws, size_t ws_size, hipStream_t stream) {
    static int grid_blocks = 0;
    if (!grid_blocks) {
        int dev = 0, cus = 0, per_cu = 0;
        (void)hipGetDevice(&dev);
        (void)hipDeviceGetAttribute(&cus, hipDeviceAttributeMultiprocessorCount, dev);
        (void)hipFuncSetAttribute((const void*)hymba_fwd, hipFuncAttributeMaxDynamicSharedMemorySize, LDS_BYTES);
        (void)hipOccupancyMaxActiveBlocksPerMultiprocessor(&per_cu, (const void*)hymba_fwd, 512, LDS_BYTES);
        (void)hipGetLastError();
        if (per_cu < 1) per_cu = 1;
        grid_blocks = cus;
        if (grid_blocks > 256) grid_blocks = 256;
    }
    Params p{};
    p.x = (const float*)d_in[0]; p.norm_g = (const float*)d_in[1]; p.w_in = (const float*)d_in[2]; p.b_ig = (const float*)d_in[3]; p.b_fg = (const float*)d_in[4];
    p.conv_w = (const float*)d_in[5]; p.conv_b = (const float*)d_in[6]; p.hn_g = (const float*)d_in[7]; p.w_out = (const float*)d_in[8]; p.fin_g = (const float*)d_in[9];
    p.out = (float*)d_out;
    unsigned char* ws = (unsigned char*)d_ws; size_t off = 0;
    p.U = (bf16_t*)(ws + off); p.HRAW = (float*)(ws + off); off += (size_t)NTOK * DM * 2;
    p.P = (bf16_t*)(ws + off); off += (size_t)NTOK * NP * 2;
    p.MIX = (bf16_t*)(ws + off); off += (size_t)NTOK * DM * 2;
    p.WIT = (bf16_t*)(ws + off); off += (size_t)NP * DM * 2;
    p.WOT = (bf16_t*)(ws + off); off += (size_t)DM * DM * 2;
    p.G = (float*)(ws + off); off += (size_t)NTOK * 8 * 4;
    p.MLG = (float*)(ws + off); off += (size_t)64 * 4 * SEQ * 4;
    p.ROWSS = (float*)(ws + off); off += (size_t)NTOK * 4;
    if (off > ws_size) { fprintf(stderr, "workspace too small: need %zu have %zu\n", off, ws_size); return; }
    void* args[] = {&p};
    hipError_t e = hipLaunchCooperativeKernel((const void*)hymba_fwd, dim3(grid_blocks), dim3(512), args, LDS_BYTES, stream);
    if (e != hipSuccess) fprintf(stderr, "cooperative launch failed: %s (grid %d)\n", hipGetErrorString(e), grid_blocks);
}
```

```cpp
#include <hip/hip_runtime.h>
#include <hip/hip_cooperative_groups.h>
#include <cstdio>
namespace cg = cooperative_groups;

#ifndef FAST_ATT
#define FAST_ATT 1
#endif
#ifndef FAST_ML
#define FAST_ML 1
#endif

#define LAS __attribute__((address_space(3)))
typedef unsigned short bf16_t;
typedef short bf16x8 __attribute__((ext_vector_type(8)));
typedef short s16x4 __attribute__((ext_vector_type(4)));
typedef float f32x4 __attribute__((ext_vector_type(4)));
typedef unsigned u32x4 __attribute__((ext_vector_type(4)));
typedef unsigned u32x2 __attribute__((ext_vector_type(2)));

constexpr int NTOK = 65536, DM = 1024, SEQ = 4096, NP = 4608, NIN = 4616;
constexpr int LDS_BYTES = 131072;
constexpr float EPS = 1e-6f;
constexpr float LOG2E = 1.4426950408889634f, LN2 = 0.6931471805599453f;

struct Params {
    const float *x, *norm_g, *w_in, *b_ig, *b_fg, *conv_w, *conv_b, *hn_g, *w_out, *fin_g;
    float* out;
    bf16_t *U, *P, *MIX, *WIT, *WOT;
    float *G, *MLG, *ROWSS, *HRAW;
};

__device__ __forceinline__ float bf2f(bf16_t b) { return __uint_as_float(((unsigned)b) << 16); }
__device__ __forceinline__ float bflo(unsigned w) { return __uint_as_float(w << 16); }
__device__ __forceinline__ float bfhi(unsigned w) { return __uint_as_float(w & 0xffff0000u); }
__device__ __forceinline__ unsigned cvt_pk_bf16(float lo, float hi) { unsigned r; asm volatile("v_cvt_pk_bf16_f32 %0, %1, %2" : "=v"(r) : "v"(lo), "v"(hi)); return r; }
__device__ __forceinline__ bf16_t f2bf(float f) { return (bf16_t)(cvt_pk_bf16(f, 0.f) & 0xffffu); }
__device__ __forceinline__ float wave_sum(float v) {
#pragma unroll
    for (int o = 1; o < 64; o <<= 1) v += __shfl_xor(v, o);
    return v;
}
__device__ __forceinline__ float sigmoidf_(float z) { return 1.f / (1.f + __expf(-z)); }

namespace pg8 {
constexpr int BM = 256, BK = 64, HALF = 128, HTB = HALF * BK * 2, NXCD = 8, WGM = 8;
__device__ __forceinline__ int lds_byte(int r, int c) { const int st = (r >> 4) * 2 + (c >> 5), rr = r & 15, cc = c & 31, ob = rr * 64 + cc * 2; return st * 1024 + (ob ^ (((ob >> 9) & 1) << 5)); }
__device__ __forceinline__ void stage_rc(int b, int& R, int& C) { const int st = b / 1024, sb = b % 1024, swz = sb ^ (((sb >> 9) & 1) << 5); R = (st >> 1) * 16 + swz / 64; C = (st & 1) * 32 + (swz % 64) / 2; }
__device__ __forceinline__ int perm32(int rho) { const int n = rho >> 4, i = rho & 15; return 8 * (i >> 2) + 4 * n + (i & 3); }
struct Unit { int pm, pn; };
struct Gemm { const bf16_t* A; const bf16_t* Bt; int M, N, K; };
struct StaticOrder {
    int nM, nN, nwg, G, c;
    __device__ void init(int M, int N, int G_, int c_) { nM = M / BM; nN = N / BM; nwg = nM * nN; G = G_; c = c_; }
    __device__ bool next(int i, Unit& u) const {
        const long L = (long)i * G + c; if (L >= nwg) return false;
        int wgid = (int)L; { const int q = nwg / NXCD, r = nwg % NXCD, xcd = wgid % NXCD, off = wgid / NXCD; wgid = (xcd < r ? xcd * (q + 1) : r * (q + 1) + (xcd - r) * q) + off; }
        const int nig = WGM * nN, gid = wgid / nig, fm = gid * WGM, gsz = (nM - fm) < WGM ? (nM - fm) : WGM;
        u.pm = fm + ((wgid % nig) % gsz); u.pn = (wgid % nig) / gsz; return true;
    }
};
struct EpiBf16 {
    static constexpr bool PERM = true;
    bf16_t* O; int ldc;
    __device__ __forceinline__ void operator()(const f32x4 (&acc)[2][2][4][2], const Unit& u, int wr, int wc, int fr, int fq) const {
        const int row0 = u.pm * BM + wr * 64 + fr; const int col0 = u.pn * BM + wc * 32 + 8 * fq;
#pragma unroll
        for (int ai = 0; ai < 2; ++ai)
#pragma unroll
            for (int m = 0; m < 4; ++m) { bf16_t* rowp = O + (size_t)(row0 + ai * HALF + m * 16) * ldc + col0;
#pragma unroll
                for (int bj = 0; bj < 2; ++bj) { const f32x4 v0 = acc[ai][bj][m][0], v1 = acc[ai][bj][m][1];
                    u32x4 w; w.x = cvt_pk_bf16(v0[0], v0[1]); w.y = cvt_pk_bf16(v0[2], v0[3]); w.z = cvt_pk_bf16(v1[0], v1[1]); w.w = cvt_pk_bf16(v1[2], v1[3]);
                    *(u32x4*)(rowp + bj * HALF) = w; } }
    }
};
struct EpiOut {
    static constexpr bool PERM = false;
    float* C; const float* X; float* rowss;
    __device__ __forceinline__ void operator()(const f32x4 (&acc)[2][2][4][2], const Unit& u, int wr, int wc, int fr, int fq) const {
        const int row0 = u.pm * BM + wr * 64 + fr, col0 = u.pn * BM + wc * 32 + 4 * fq;
#pragma unroll
        for (int ai = 0; ai < 2; ++ai)
#pragma unroll
            for (int m = 0; m < 4; ++m) { const int row = row0 + ai * HALF + m * 16; float* rowp = C + (size_t)row * DM + col0; const float* xp = X + (size_t)row * DM + col0; float ss = 0.f;
#pragma unroll
                for (int bj = 0; bj < 2; ++bj)
#pragma unroll
                    for (int n = 0; n < 2; ++n) { const f32x4 xv = *(const f32x4*)(xp + bj * HALF + n * 16); const f32x4 hv = xv + acc[ai][bj][m][n];
                        *(f32x4*)(rowp + bj * HALF + n * 16) = hv; ss += (hv[0] * hv[0] + hv[1] * hv[1]) + (hv[2] * hv[2] + hv[3] * hv[3]); }
                ss += __shfl_xor(ss, 16); ss += __shfl_xor(ss, 32);
                if (fq == 0) atomicAdd(rowss + row, ss); }
    }
};

template <class Epi>
__device__ __forceinline__ void gemm_phase(LAS unsigned char* lds, const Gemm g, const StaticOrder& S, const Epi& E) {
    const int tid = threadIdx.x, wid = __builtin_amdgcn_readfirstlane(tid >> 6), lane = tid & 63, wr = wid >> 2, wc = wid & 3, fr = lane & 15, fq = lane >> 4;
    const int K = g.K, nt = K / BK;
    unsigned voffA[2], voffB[2];
#pragma unroll
    for (int i = 0; i < 2; ++i) { int R, C; stage_rc(tid * 16 + i * 8192, R, C); const int Rb = Epi::PERM ? ((R & ~31) + perm32(R & 31)) : R;
        voffA[i] = (unsigned)(R * K + C) * 2u; voffB[i] = (unsigned)(Rb * K + C) * 2u; }
    const size_t kstep = (size_t)(BK * 2);
    const size_t hstep = (size_t)HALF * K * 2;
    const size_t tstep = 2 * hstep;
    const unsigned ldsw = (unsigned)wid * 1024u;
    const int aoff = lds_byte(wr * 64 + fr, fq * 8), boff = lds_byte(wc * 32 + fr, fq * 8);
#define PG8_SA(b, h) (((b) * 2 + (h)) * HTB)
#define PG8_SB(b, h) ((4 + (b) * 2 + (h)) * HTB)
#define PG8_STAGE(bufoff, gbase, voff) do { _Pragma("unroll") for (int _i = 0; _i < 2; ++_i) \
        __builtin_amdgcn_global_load_lds((const unsigned*)((const char*)(gbase) + (voff)[_i]), (LAS unsigned*)(lds + (bufoff) + ldsw + _i * 8192), 16, 0, 0); } while (0)
#define PG8_LDA(dst, b, h) do { _Pragma("unroll") for (int m = 0; m < 4; ++m) _Pragma("unroll") for (int k = 0; k < 2; ++k) dst[m][k] = *(const LAS bf16x8*)(lds + PG8_SA(b, h) + aoff + m * 2048 + k * 1024); } while (0)
#define PG8_LDB(dst, b, h) do { _Pragma("unroll") for (int n = 0; n < 2; ++n) _Pragma("unroll") for (int k = 0; k < 2; ++k) dst[n][k] = *(const LAS bf16x8*)(lds + PG8_SB(b, h) + boff + n * 2048 + k * 1024); } while (0)
#define PG8_MMA(ai, bj, At, Bt) do { __builtin_amdgcn_s_setprio(1); _Pragma("unroll") for (int m = 0; m < 4; ++m) _Pragma("unroll") for (int n = 0; n < 2; ++n) _Pragma("unroll") for (int k = 0; k < 2; ++k) \
        acc[ai][bj][m][n] = __builtin_amdgcn_mfma_f32_16x16x32_bf16(Bt[n][k], At[m][k], acc[ai][bj][m][n], 0, 0, 0); __builtin_amdgcn_s_setprio(0); } while (0)
#define PG8_WAIT_V(n) asm volatile("s_waitcnt vmcnt(" #n ")" ::: "memory")
#define PG8_WAIT_L(n) asm volatile("s_waitcnt lgkmcnt(" #n ")" ::: "memory")
#define PG8_BAR __builtin_amdgcn_s_barrier()
#define PG8_SCHED __builtin_amdgcn_sched_barrier(0)
    Unit cur, nxt; int ui = 0;
    if (!S.next(0, cur)) return;
    f32x4 acc[2][2][4][2];
#pragma unroll
    for (int a = 0; a < 2; ++a)
#pragma unroll
        for (int b = 0; b < 2; ++b)
#pragma unroll
            for (int m = 0; m < 4; ++m)
#pragma unroll
                for (int n = 0; n < 2; ++n) acc[a][b][m][n] = (f32x4){0.f, 0.f, 0.f, 0.f};
    bf16x8 At[4][2], B0[2][2], B1[2][2];
    const char* cA = (const char*)g.A + (size_t)cur.pm * tstep; const char* cB = (const char*)g.Bt + (size_t)cur.pn * tstep;
    PG8_STAGE(PG8_SB(0, 0), cB, voffB); PG8_STAGE(PG8_SA(0, 0), cA, voffA); PG8_STAGE(PG8_SB(0, 1), cB + hstep, voffB); PG8_STAGE(PG8_SA(0, 1), cA + hstep, voffA);
    if (wr == 1) PG8_BAR;
    PG8_WAIT_V(4); PG8_BAR;
    PG8_STAGE(PG8_SB(1, 0), cB + kstep, voffB); PG8_STAGE(PG8_SA(1, 0), cA + kstep, voffA); PG8_STAGE(PG8_SB(1, 1), cB + hstep + kstep, voffB);
    PG8_WAIT_V(6); PG8_BAR;
    for (;;) {
        const bool has_next = S.next(ui + 1, nxt);
        const char* nA = has_next ? (const char*)g.A + (size_t)nxt.pm * tstep : cA; const char* nB = has_next ? (const char*)g.Bt + (size_t)nxt.pn * tstep : cB;
        for (int t = 0; t < nt; t += 2) {
            const bool last = (t == nt - 2);
            const char* a1 = cA + (size_t)(t + 1) * kstep;
            const char* a2 = last ? nA : cA + (size_t)(t + 2) * kstep; const char* b2 = last ? nB : cB + (size_t)(t + 2) * kstep;
            const char* a3 = a2 + kstep; const char* b3 = b2 + kstep;
            PG8_LDB(B0, 0, 0); PG8_SCHED; PG8_LDA(At, 0, 0); PG8_STAGE(PG8_SA(1, 1), a1 + hstep, voffA);
            PG8_WAIT_L(8); PG8_BAR; PG8_WAIT_L(0); PG8_MMA(0, 0, At, B0); PG8_BAR; PG8_SCHED;
            PG8_LDB(B1, 0, 1); PG8_STAGE(PG8_SB(0, 0), b2, voffB);
            PG8_BAR; PG8_WAIT_L(0); PG8_MMA(0, 1, At, B1); PG8_BAR;
            PG8_LDA(At, 0, 1); PG8_STAGE(PG8_SA(0, 0), a2, voffA);
            PG8_BAR; PG8_WAIT_L(0); PG8_MMA(1, 0, At, B0); PG8_BAR; PG8_SCHED;
            PG8_STAGE(PG8_SB(0, 1), b2 + hstep, voffB);
            PG8_WAIT_V(6); PG8_BAR; PG8_MMA(1, 1, At, B1); PG8_BAR;
            PG8_LDB(B0, 1, 0); PG8_SCHED; PG8_LDA(At, 1, 0); PG8_STAGE(PG8_SA(0, 1), a2 + hstep, voffA);
            PG8_WAIT_L(8); PG8_BAR; PG8_WAIT_L(0); PG8_MMA(0, 0, At, B0); PG8_BAR; PG8_SCHED;
            PG8_LDB(B1, 1, 1); PG8_STAGE(PG8_SB(1, 0), b3, voffB);
            PG8_BAR; PG8_WAIT_L(0); PG8_MMA(0, 1, At, B1); PG8_BAR;
            PG8_LDA(At, 1, 1); PG8_STAGE(PG8_SA(1, 0), a3, voffA);
            PG8_BAR; PG8_WAIT_L(0); PG8_MMA(1, 0, At, B0); PG8_BAR; PG8_SCHED;
            PG8_STAGE(PG8_SB(1, 1), b3 + hstep, voffB);
            PG8_WAIT_V(6); PG8_BAR; PG8_MMA(1, 1, At, B1); PG8_BAR;
        }
        E(acc, cur, wr, wc, fr, fq);
        if (!has_next) break;
#pragma unroll
        for (int a = 0; a < 2; ++a)
#pragma unroll
            for (int b = 0; b < 2; ++b)
#pragma unroll
                for (int m = 0; m < 4; ++m)
#pragma unroll
                    for (int n = 0; n < 2; ++n) acc[a][b][m][n] = (f32x4){0.f, 0.f, 0.f, 0.f};
        cur = nxt; cA = nA; cB = nB; ++ui;
    }
    PG8_WAIT_V(0);
    if (wr == 0) PG8_BAR;
    PG8_BAR;
#undef PG8_SA
#undef PG8_SB
#undef PG8_STAGE
#undef PG8_LDA
#undef PG8_LDB
#undef PG8_MMA
#undef PG8_WAIT_V
#undef PG8_WAIT_L
#undef PG8_BAR
#undef PG8_SCHED
}
}

__device__ __forceinline__ void phase_prep(const Params& p) {
    const int tid = threadIdx.x, lane = tid & 63, wid = tid >> 6;
    const int gt = blockIdx.x * 512 + tid, NGT = gridDim.x * 512;
    for (int i = gt; i < NTOK; i += NGT) p.ROWSS[i] = 0.f;
    for (int it = gt; it < NP * 128; it += NGT) {
        const int n = it % NP, k8 = it / NP; const float sc = n < 512 ? 0.125f : 1.0f;
        float v[8];
#pragma unroll
        for (int j = 0; j < 8; ++j) v[j] = p.w_in[(size_t)(k8 * 8 + j) * NIN + n] * sc;
        u32x4 w; w.x = cvt_pk_bf16(v[0], v[1]); w.y = cvt_pk_bf16(v[2], v[3]); w.z = cvt_pk_bf16(v[4], v[5]); w.w = cvt_pk_bf16(v[6], v[7]);
        *(u32x4*)(p.WIT + (size_t)n * DM + k8 * 8) = w;
    }
    for (int it = gt; it < DM * 128; it += NGT) {
        const int n = it % DM, k8 = it / DM;
        float v[8];
#pragma unroll
        for (int j = 0; j < 8; ++j) v[j] = p.w_out[(size_t)(k8 * 8 + j) * DM + n];
        u32x4 w; w.x = cvt_pk_bf16(v[0], v[1]); w.y = cvt_pk_bf16(v[2], v[3]); w.z = cvt_pk_bf16(v[4], v[5]); w.w = cvt_pk_bf16(v[6], v[7]);
        *(u32x4*)(p.WOT + (size_t)n * DM + k8 * 8) = w;
    }
    float gk[16], wg[16][8];
#pragma unroll
    for (int j = 0; j < 4; ++j)
#pragma unroll
        for (int e = 0; e < 4; ++e) { const int k = 4 * lane + 256 * j + e; const float g = p.norm_g[k]; gk[j * 4 + e] = g;
#pragma unroll
            for (int c = 0; c < 8; ++c) wg[j * 4 + e][c] = g * p.w_in[(size_t)k * NIN + NP + c]; }
    const float bias = (lane < 4) ? p.b_ig[lane] : (lane < 8 ? p.b_fg[lane - 4] : 0.f);
    const int gw = blockIdx.x * 8 + wid, NGW = gridDim.x * 8;
    f32x4 v[4], vn[4];
    if (gw < NTOK) {
#pragma unroll
        for (int j = 0; j < 4; ++j) v[j] = *(const f32x4*)(p.x + (size_t)gw * DM + 4 * lane + 256 * j);
    }
    for (int row = gw; row < NTOK; row += NGW) {
        const int nrow = row + NGW;
        if (nrow < NTOK) {
#pragma unroll
            for (int j = 0; j < 4; ++j) vn[j] = *(const f32x4*)(p.x + (size_t)nrow * DM + 4 * lane + 256 * j);
        }
        float ss = 0.f;
#pragma unroll
        for (int j = 0; j < 4; ++j) ss += (v[j][0] * v[j][0] + v[j][1] * v[j][1]) + (v[j][2] * v[j][2] + v[j][3] * v[j][3]);
        ss = wave_sum(ss);
        const float rstd = rsqrtf(ss * (1.f / DM) + EPS);
        float gacc[8];
#pragma unroll
        for (int c = 0; c < 8; ++c) gacc[c] = 0.f;
#pragma unroll
        for (int j = 0; j < 4; ++j) {
#pragma unroll
            for (int e = 0; e < 4; ++e) {
#pragma unroll
                for (int c = 0; c < 8; ++c) gacc[c] += v[j][e] * wg[j * 4 + e][c];
            }
            u32x2 w; w.x = cvt_pk_bf16(v[j][0] * rstd * gk[j * 4 + 0], v[j][1] * rstd * gk[j * 4 + 1]); w.y = cvt_pk_bf16(v[j][2] * rstd * gk[j * 4 + 2], v[j][3] * rstd * gk[j * 4 + 3]);
            *(u32x2*)(p.U + (size_t)row * DM + 4 * lane + 256 * j) = w;
        }
        float mine = 0.f;
#pragma unroll
        for (int c = 0; c < 8; ++c) { const float s = wave_sum(gacc[c]); mine = (lane == c) ? s : mine; }
        if (lane < 8) p.G[(size_t)row * 8 + lane] = mine * rstd + bias;
#pragma unroll
        for (int j = 0; j < 4; ++j) v[j] = vn[j];
    }
}

__device__ __forceinline__ float softplus_acc(float z) { return fmaxf(z, 0.f) + log1pf(expf(-fabsf(z))); }

__device__ void att_naive(const Params& p, int nb_first, int nb_count) {
    const int tix = ((int)blockIdx.x - nb_first) * 512 + (int)threadIdx.x, nthr = nb_count * 512;
    for (int idx = tix; idx < 16 * 8 * SEQ; idx += nthr) {
        const int t = idx & (SEQ - 1), h = (idx >> 12) & 7, b = idx >> 15;
        const size_t row = (size_t)b * SEQ + t;
        const bf16_t* qp = p.P + row * NP + h * 64;
        float q[64], acc[64];
#pragma unroll
        for (int c = 0; c < 8; ++c) { const u32x4 w = *(const u32x4*)(qp + 8 * c);
#pragma unroll
            for (int e = 0; e < 4; ++e) { q[8 * c + 2 * e] = bflo(w[e]); q[8 * c + 2 * e + 1] = bfhi(w[e]); } }
#pragma unroll
        for (int d = 0; d < 64; ++d) acc[d] = 0.f;
        float carry = 0.f;
        for (int s = t - 1; s >= 0; --s) {
            const bf16_t* kp = p.P + ((size_t)b * SEQ + s) * NP + 512 + h * 64;
            const bf16_t* vp = kp + 512;
            float z = 0.f;
#pragma unroll
            for (int c = 0; c < 8; ++c) { const u32x4 w = *(const u32x4*)(kp + 8 * c);
#pragma unroll
                for (int e = 0; e < 4; ++e) { z += q[8 * c + 2 * e] * bflo(w[e]); z += q[8 * c + 2 * e + 1] * bfhi(w[e]); } }
            const float sp = softplus_acc(z);
            const float wgt = expf(z - sp + carry);
#pragma unroll
            for (int c = 0; c < 8; ++c) { const u32x4 w = *(const u32x4*)(vp + 8 * c);
#pragma unroll
                for (int e = 0; e < 4; ++e) { acc[8 * c + 2 * e] += wgt * bflo(w[e]); acc[8 * c + 2 * e + 1] += wgt * bfhi(w[e]); } }
            carry -= sp;
            if (carry < -104.f) break;
        }
        const bf16_t* zp = p.P + row * NP + 1536 + h * 64;
        bf16_t* op = p.MIX + row * DM + h * 64;
#pragma unroll
        for (int c = 0; c < 8; ++c) { const u32x4 w = *(const u32x4*)(zp + 8 * c); u32x4 o;
#pragma unroll
            for (int e = 0; e < 4; ++e) { const float z0 = bflo(w[e]), z1 = bfhi(w[e]);
                o[e] = cvt_pk_bf16(acc[8 * c + 2 * e] * z0 * sigmoidf_(z0), acc[8 * c + 2 * e + 1] * z1 * sigmoidf_(z1)); }
            *(u32x4*)(op + 8 * c) = o; }
    }
}

constexpr int AT_ROWB = 144, AT_TILE = 64 * AT_ROWB;
__device__ __forceinline__ s16x4 tr_read4(LAS unsigned char* p) { return __builtin_amdgcn_ds_read_tr16_b64_v4i16((LAS s16x4*)p); }

__device__ void att_fast(const Params& p, LAS unsigned char* lds, int nb_first, int nb_count) {
    const int tid = threadIdx.x, wid = __builtin_amdgcn_readfirstlane(tid >> 6), lane = tid & 63, fr = lane & 15, fq = lane >> 4;
    LAS int* flags = (LAS int*)(lds + 4 * AT_TILE);
    bf16x8 T0, T1, TONE;
#pragma unroll
    for (int jj = 0; jj < 8; ++jj) { const int j = 16 * (jj >> 2) + 4 * fq + (jj & 3); T0[jj] = (j > fr) ? (short)0x3F80 : (short)0; T1[jj] = (j > 16 + fr) ? (short)0x3F80 : (short)0; TONE[jj] = (short)0x3F80; }
    const int srow = tid >> 3, sch = tid & 7;
    for (int u = (int)blockIdx.x - nb_first; u < 16 * 8 * 32; u += nb_count) {
        const int qb = u & 31, h = (u >> 5) & 7, b = u >> 8;
        const int qw0 = qb * 128 + 16 * wid, tq = qw0 + fr;
        const size_t rowq = (size_t)b * SEQ + tq;
        bf16x8 Qf[2];
#pragma unroll
        for (int t = 0; t < 2; ++t) Qf[t] = *(const bf16x8*)(p.P + rowq * NP + h * 64 + 32 * t + 8 * fq);
        f32x4 oacc[4];
#pragma unroll
        for (int d = 0; d < 4; ++d) oacc[d] = (f32x4){0.f, 0.f, 0.f, 0.f};
        float carry = 0.f;
        const int ktop = 2 * qb + 1;
        const bf16_t* kvbase = p.P + ((size_t)b * SEQ + srow) * NP + 512 + h * 64 + sch * 8;
        u32x4 kreg = *(const u32x4*)(kvbase + (size_t)(64 * ktop) * NP), vreg = *(const u32x4*)(kvbase + (size_t)(64 * ktop) * NP + 512);
        *(LAS u32x4*)(lds + srow * AT_ROWB + sch * 16) = kreg; *(LAS u32x4*)(lds + AT_TILE + srow * AT_ROWB + sch * 16) = vreg;
        __syncthreads();
        for (int it = 0;; ++it) {
            const int kt = ktop - it, buf = it & 1, k0 = 64 * kt;
            if (kt > 0) { kreg = *(const u32x4*)(kvbase + (size_t)(k0 - 64) * NP); vreg = *(const u32x4*)(kvbase + (size_t)(k0 - 64) * NP + 512); }
            const bool wdone = __all(carry < -104.f);
            if (!wdone && k0 <= qw0 + 15) {
                LAS unsigned char* Kb = lds + buf * 2 * AT_TILE; LAS unsigned char* Vb = Kb + AT_TILE;
                f32x4 z[4];
#pragma unroll
                for (int k4 = 0; k4 < 4; ++k4) { z[k4] = (f32x4){0.f, 0.f, 0.f, 0.f};
#pragma unroll
                    for (int t = 0; t < 2; ++t) { const bf16x8 A = *(const LAS bf16x8*)(Kb + (16 * k4 + fr) * AT_ROWB + (32 * t + 8 * fq) * 2);
                        z[k4] = __builtin_amdgcn_mfma_f32_16x16x32_bf16(A, Qf[t], z[k4], 0, 0, 0); } }
                float lneg[4][4], lpos[4][4];
#pragma unroll
                for (int k4 = 0; k4 < 4; ++k4)
#pragma unroll
                    for (int r = 0; r < 4; ++r) { const float a = z[k4][r]; const bool strict = (k0 + 16 * k4 + 4 * fq + r) < tq;
                        const float e = __builtin_amdgcn_exp2f(-fabsf(a) * LOG2E);
                        const float sp = fmaxf(a, 0.f) + LN2 * __builtin_amdgcn_logf(1.f + e);
                        lneg[k4][r] = strict ? -sp : 0.f; lpos[k4][r] = a - sp; }
                bf16x8 Lf[2];
#pragma unroll
                for (int t = 0; t < 2; ++t) { u32x4 w; w.x = cvt_pk_bf16(lneg[2 * t][0], lneg[2 * t][1]); w.y = cvt_pk_bf16(lneg[2 * t][2], lneg[2 * t][3]);
                    w.z = cvt_pk_bf16(lneg[2 * t + 1][0], lneg[2 * t + 1][1]); w.w = cvt_pk_bf16(lneg[2 * t + 1][2], lneg[2 * t + 1][3]); Lf[t] = __builtin_bit_cast(bf16x8, w); }
                const f32x4 c4 = (f32x4){carry, carry, carry, carry};
                f32x4 E[4];
                E[0] = __builtin_amdgcn_mfma_f32_16x16x32_bf16(T0, Lf[0], c4, 0, 0, 0); E[0] = __builtin_amdgcn_mfma_f32_16x16x32_bf16(TONE, Lf[1], E[0], 0, 0, 0);
                E[1] = __builtin_amdgcn_mfma_f32_16x16x32_bf16(T1, Lf[0], c4, 0, 0, 0); E[1] = __builtin_amdgcn_mfma_f32_16x16x32_bf16(TONE, Lf[1], E[1], 0, 0, 0);
                E[2] = __builtin_amdgcn_mfma_f32_16x16x32_bf16(T0, Lf[1], c4, 0, 0, 0);
                E[3] = __builtin_amdgcn_mfma_f32_16x16x32_bf16(T1, Lf[1], c4, 0, 0, 0);
                float aw[4][4];
#pragma unroll
                for (int k4 = 0; k4 < 4; ++k4)
#pragma unroll
                    for (int r = 0; r < 4; ++r) { const bool strict = (k0 + 16 * k4 + 4 * fq + r) < tq;
                        const float ex = __builtin_amdgcn_exp2f((lpos[k4][r] + E[k4][r]) * LOG2E); aw[k4][r] = strict ? ex : 0.f; }
                const float tot = E[0][0] + lneg[0][0];
                carry = __shfl(tot, fr);
                bf16x8 Af[2];
#pragma unroll
                for (int t = 0; t < 2; ++t) { u32x4 w; w.x = cvt_pk_bf16(aw[2 * t][0], aw[2 * t][1]); w.y = cvt_pk_bf16(aw[2 * t][2], aw[2 * t][3]);
                    w.z = cvt_pk_bf16(aw[2 * t + 1][0], aw[2 * t + 1][1]); w.w = cvt_pk_bf16(aw[2 * t + 1][2], aw[2 * t + 1][3]); Af[t] = __builtin_bit_cast(bf16x8, w); }
#pragma unroll
                for (int d = 0; d < 4; ++d)
#pragma unroll
                    for (int t = 0; t < 2; ++t) { LAS unsigned char* a0 = Vb + (32 * t + 4 * fq + (fr >> 2)) * AT_ROWB + (16 * d + 4 * (fr & 3)) * 2;
                        const s16x4 lo = tr_read4(a0), hi = tr_read4(a0 + 16 * AT_ROWB);
                        const bf16x8 Vf = __builtin_shufflevector(lo, hi, 0, 1, 2, 3, 4, 5, 6, 7);
                        oacc[d] = __builtin_amdgcn_mfma_f32_16x16x32_bf16(Vf, Af[t], oacc[d], 0, 0, 0); }
            }
            const bool wdone2 = __all(carry < -104.f);
            if (lane == 0) flags[buf * 8 + wid] = wdone2 ? 1 : 0;
            if (kt > 0) { *(LAS u32x4*)(lds + (buf ^ 1) * 2 * AT_TILE + srow * AT_ROWB + sch * 16) = kreg; *(LAS u32x4*)(lds + (buf ^ 1) * 2 * AT_TILE + AT_TILE + srow * AT_ROWB + sch * 16) = vreg; }
            __syncthreads();
            if (kt == 0) break;
            int alld = 1;
#pragma unroll
            for (int w = 0; w < 8; ++w) alld &= flags[buf * 8 + w];
            if (alld) break;
        }
#pragma unroll
        for (int d = 0; d < 4; ++d) { const int col = h * 64 + 16 * d + 4 * fq;
            const u32x2 zw = *(const u32x2*)(p.P + rowq * NP + 1536 + col);
            const float z0 = bflo(zw.x), z1 = bfhi(zw.x), z2 = bflo(zw.y), z3 = bfhi(zw.y);
            u32x2 o; o.x = cvt_pk_bf16(oacc[d][0] * z0 * sigmoidf_(z0), oacc[d][1] * z1 * sigmoidf_(z1)); o.y = cvt_pk_bf16(oacc[d][2] * z2 * sigmoidf_(z2), oacc[d][3] * z3 * sigmoidf_(z3));
            *(u32x2*)(p.MIX + rowq * DM + col) = o; }
    }
}

constexpr int ML_QROW = 272, ML_TROW = 144, ML_HROW = 528;
constexpr int ML_Q = 0, ML_K = 17408, ML_KT = 34816, ML_VT = 53248, ML_SB = 71680, ML_H = 80896;
constexpr int ML_GA = 114688, ML_GM = ML_GA + 256, ML_GIW = ML_GM + 256, ML_GEN = ML_GIW + 256, ML_GW = ML_GEN + 256, ML_N = ML_GW + 256, ML_RDEN = ML_N + 512, ML_SCAN = ML_RDEN + 256;

__device__ void ml_fast(const Params& p, LAS unsigned char* lds) {
    const int bh = blockIdx.x; if (bh >= 64) return;
    const int b = bh >> 2, h = bh & 3, tid = threadIdx.x, lane = tid & 63, wid = __builtin_amdgcn_readfirstlane(tid >> 6), fr = lane & 15, fq = lane >> 4;
    float* mlg = p.MLG + (size_t)bh * 4 * SEQ;
    {
        LAS float* scan = (LAS float*)(lds + ML_SCAN);
        float a_[8], pm_[8], bc_[8];
#pragma unroll
        for (int i = 0; i < 8; ++i) {
            const int c = wid + 8 * i; const size_t tok = (size_t)b * SEQ + 64 * c + lane;
            const float ig = p.G[tok * 8 + h], fg = p.G[tok * 8 + 4 + h];
            float bc = -softplus_acc(-fg);
#pragma unroll
            for (int o = 1; o < 64; o <<= 1) { const float t = __shfl_up(bc, o); if (lane >= o) bc += t; }
            const float a = ig - bc; float pm = a;
#pragma unroll
            for (int o = 1; o < 64; o <<= 1) { const float t = __shfl_up(pm, o); if (lane >= o) pm = fmaxf(pm, t); }
            a_[i] = a; pm_[i] = pm; bc_[i] = bc;
            if (lane == 63) { scan[c] = bc; scan[64 + c] = pm; }
        }
        __syncthreads();
        if (tid == 0) { float m = 0.f; for (int c = 0; c < 64; ++c) { scan[128 + c] = m; m = scan[c] + fmaxf(m, scan[64 + c]); } }
        __syncthreads();
#pragma unroll
        for (int i = 0; i < 8; ++i) {
            const int c = wid + 8 * i; const float mc = scan[128 + c]; const float M = fmaxf(mc, pm_[i]);
            const int o = 64 * c + lane;
            mlg[o] = a_[i]; mlg[SEQ + o] = M; mlg[2 * SEQ + o] = expf(mc - M); mlg[3 * SEQ + o] = expf(-(bc_[i] + M));
        }
        if (tid < 128) *(LAS float*)(lds + ML_N + tid * 4) = 0.f;
        __syncthreads();
    }
    const int isK = tid >> 8, rg = (tid >> 4) & 15, cg = tid & 15;
    float cw[4][8], cb[8];
    {
        const int ch = isK * 512 + h * 128 + 8 * cg; const float sc = isK ? 0.08838834764831845f : 1.0f;
#pragma unroll
        for (int e = 0; e < 8; ++e) { cb[e] = p.conv_b[ch + e] * sc;
#pragma unroll
            for (int j = 0; j < 4; ++j) cw[j][e] = p.conv_w[j * 1024 + ch + e] * sc; }
    }
    const int vrg = tid >> 5, vcg = tid & 31;
    const int el = tid >> 3, ep = tid & 7;
    const bf16_t* qkbase = p.P + (size_t)b * SEQ * NP + (isK ? 2560 : 2048) + h * 128 + 8 * cg;
    const bf16_t* vbase = p.P + (size_t)b * SEQ * NP + 3072 + h * 128 + 4 * vcg;
    f32x4 Cst[8];
#pragma unroll
    for (int m = 0; m < 8; ++m) Cst[m] = (f32x4){0.f, 0.f, 0.f, 0.f};
    u32x4 raw[7]; u32x2 vraw[4]; float graw = 0.f;
#pragma unroll
    for (int i = 0; i < 7; ++i) { const int r = 4 * rg - 3 + i; raw[i] = (r >= 0) ? *(const u32x4*)(qkbase + (size_t)r * NP) : (u32x4){0u, 0u, 0u, 0u}; }
#pragma unroll
    for (int i = 0; i < 4; ++i) vraw[i] = *(const u32x2*)(vbase + (size_t)(4 * vrg + i) * NP);
    if (tid < 256) graw = mlg[(tid >> 6) * SEQ + (tid & 63)];

    for (int c = 0; c < 64; ++c) {
        {
            float o[4][8];
#pragma unroll
            for (int i = 0; i < 4; ++i)
#pragma unroll
                for (int e = 0; e < 8; ++e) o[i][e] = cb[e];
#pragma unroll
            for (int rr = 0; rr < 7; ++rr) {
                float in[8];
#pragma unroll
                for (int e = 0; e < 4; ++e) { in[2 * e] = bflo(raw[rr][e]); in[2 * e + 1] = bfhi(raw[rr][e]); }
#pragma unroll
                for (int i = 0; i < 4; ++i) { const int j = rr - i; if (j >= 0 && j < 4) {
#pragma unroll
                    for (int e = 0; e < 8; ++e) o[i][e] += cw[j][e] * in[e]; } }
            }
            unsigned pk[4][4];
#pragma unroll
            for (int i = 0; i < 4; ++i)
#pragma unroll
                for (int e = 0; e < 4; ++e) pk[i][e] = cvt_pk_bf16(o[i][2 * e], o[i][2 * e + 1]);
            LAS unsigned char* nat = lds + (isK ? ML_K : ML_Q);
#pragma unroll
            for (int i = 0; i < 4; ++i) *(LAS u32x4*)(nat + (4 * rg + i) * ML_QROW + cg * 16) = (u32x4){pk[i][0], pk[i][1], pk[i][2], pk[i][3]};
            if (isK) {
#pragma unroll
                for (int e = 0; e < 8; ++e) { const int w = e >> 1; unsigned w0, w1;
                    if (e & 1) { w0 = (pk[0][w] >> 16) | (pk[1][w] & 0xffff0000u); w1 = (pk[2][w] >> 16) | (pk[3][w] & 0xffff0000u); }
                    else { w0 = (pk[0][w] & 0xffffu) | (pk[1][w] << 16); w1 = (pk[2][w] & 0xffffu) | (pk[3][w] << 16); }
                    *(LAS u32x2*)(lds + ML_KT + (8 * cg + e) * ML_TROW + 8 * rg) = (u32x2){w0, w1}; }
            }
#pragma unroll
            for (int e = 0; e < 4; ++e) { unsigned w0, w1;
                if (e & 1) { w0 = (vraw[0][e >> 1] >> 16) | (vraw[1][e >> 1] & 0xffff0000u); w1 = (vraw[2][e >> 1] >> 16) | (vraw[3][e >> 1] & 0xffff0000u); }
                else { w0 = (vraw[0][e >> 1] & 0xffffu) | (vraw[1][e >> 1] << 16); w1 = (vraw[2][e >> 1] & 0xffffu) | (vraw[3][e >> 1] << 16); }
                *(LAS u32x2*)(lds + ML_VT + (4 * vcg + e) * ML_TROW + 8 * vrg) = (u32x2){w0, w1}; }
            if (tid < 256) *(LAS float*)(lds + ML_GA + tid * 4) = graw;
        }
        if (c < 63) {
            const int r0 = 64 * (c + 1);
#pragma unroll
            for (int i = 0; i < 7; ++i) raw[i] = *(const u32x4*)(qkbase + (size_t)(r0 + 4 * rg - 3 + i) * NP);
#pragma unroll
            for (int i = 0; i < 4; ++i) vraw[i] = *(const u32x2*)(vbase + (size_t)(r0 + 4 * vrg + i) * NP);
            if (tid < 256) graw = mlg[(tid >> 6) * SEQ + r0 + (tid & 63)];
        }
        const size_t erow = (size_t)b * SEQ + 64 * c + el;
        u32x4 oraw[2], zraw[2];
#pragma unroll
        for (int i = 0; i < 2; ++i) { oraw[i] = *(const u32x4*)(p.P + erow * NP + 3584 + h * 128 + 16 * ep + 8 * i); zraw[i] = *(const u32x4*)(p.P + erow * NP + 4096 + h * 128 + 16 * ep + 8 * i); }
        __syncthreads();
        if (tid < 64) *(LAS float*)(lds + ML_GW + tid * 4) = __expf(*(LAS float*)(lds + ML_GA + tid * 4) - *(LAS float*)(lds + ML_GM + 63 * 4));
        {
            const int lt = wid >> 1;
#pragma unroll
            for (int si = 0; si < 2; ++si) {
                const int st = 2 * (wid & 1) + si;
                f32x4 acc = (f32x4){0.f, 0.f, 0.f, 0.f};
                float val[4] = {0.f, 0.f, 0.f, 0.f};
                if (st <= lt) {
#pragma unroll
                    for (int t = 0; t < 4; ++t) { const bf16x8 A = *(const LAS bf16x8*)(lds + ML_Q + (16 * lt + fr) * ML_QROW + (32 * t + 8 * fq) * 2);
                        const bf16x8 B = *(const LAS bf16x8*)(lds + ML_K + (16 * st + fr) * ML_QROW + (32 * t + 8 * fq) * 2);
                        acc = __builtin_amdgcn_mfma_f32_16x16x32_bf16(A, B, acc, 0, 0, 0); }
                    const float as = *(LAS float*)(lds + ML_GA + (16 * st + fr) * 4);
                    const f32x4 Ml = *(const LAS f32x4*)(lds + ML_GM + (16 * lt + 4 * fq) * 4);
#pragma unroll
                    for (int r = 0; r < 4; ++r) val[r] = (16 * st + fr <= 16 * lt + 4 * fq + r) ? acc[r] * __expf(as - Ml[r]) : 0.f;
                }
#pragma unroll
                for (int r = 0; r < 4; ++r) *(LAS bf16_t*)(lds + ML_SB + (16 * lt + 4 * fq + r) * ML_TROW + (16 * st + fr) * 2) = f2bf(val[r]);
            }
        }
        __syncthreads();
        {
            const u32x4 sw = *(const LAS u32x4*)(lds + ML_SB + el * ML_TROW + ep * 16);
            float rs = 0.f;
#pragma unroll
            for (int e = 0; e < 4; ++e) rs += bflo(sw[e]) + bfhi(sw[e]);
            float qn = 0.f;
#pragma unroll
            for (int i = 0; i < 2; ++i) { const u32x4 qw = *(const LAS u32x4*)(lds + ML_Q + el * ML_QROW + ep * 32 + i * 16);
                const f32x4 n0 = *(const LAS f32x4*)(lds + ML_N + (16 * ep + 8 * i) * 4), n1 = *(const LAS f32x4*)(lds + ML_N + (16 * ep + 8 * i + 4) * 4);
                qn += bflo(qw[0]) * n0[0] + bfhi(qw[0]) * n0[1] + bflo(qw[1]) * n0[2] + bfhi(qw[1]) * n0[3];
                qn += bflo(qw[2]) * n1[0] + bfhi(qw[2]) * n1[1] + bflo(qw[3]) * n1[2] + bfhi(qw[3]) * n1[3]; }
#pragma unroll
            for (int o = 1; o < 8; o <<= 1) { rs += __shfl_xor(rs, o); qn += __shfl_xor(qn, o); }
            if (ep == 0) { const float den = *(LAS float*)(lds + ML_GIW + el * 4) * qn + rs;
                *(LAS float*)(lds + ML_RDEN + el * 4) = 1.f / fmaxf(fabsf(den), *(LAS float*)(lds + ML_GEN + el * 4)); }
        }
        f32x4 acc[4];
        {
            bf16x8 Cb[4];
#pragma unroll
            for (int t = 0; t < 4; ++t) { u32x4 w; w.x = cvt_pk_bf16(Cst[2 * t][0], Cst[2 * t][1]); w.y = cvt_pk_bf16(Cst[2 * t][2], Cst[2 * t][3]);
                w.z = cvt_pk_bf16(Cst[2 * t + 1][0], Cst[2 * t + 1][1]); w.w = cvt_pk_bf16(Cst[2 * t + 1][2], Cst[2 * t + 1][3]); Cb[t] = __builtin_bit_cast(bf16x8, w); }
#pragma unroll
            for (int mt = 0; mt < 4; ++mt) {
                acc[mt] = (f32x4){0.f, 0.f, 0.f, 0.f};
#pragma unroll
                for (int t = 0; t < 4; ++t) { LAS unsigned char* qa = lds + ML_Q + (16 * mt + fr) * ML_QROW + (32 * t + 4 * fq) * 2;
                    const u32x2 lo = *(const LAS u32x2*)qa, hi = *(const LAS u32x2*)(qa + 32);
                    const bf16x8 A = __builtin_bit_cast(bf16x8, (u32x4){lo.x, lo.y, hi.x, hi.y});
                    acc[mt] = __builtin_amdgcn_mfma_f32_16x16x32_bf16(A, Cb[t], acc[mt], 0, 0, 0); }
                const f32x4 iw = *(const LAS f32x4*)(lds + ML_GIW + (16 * mt + 4 * fq) * 4);
                acc[mt] = acc[mt] * iw;
#pragma unroll
                for (int t = 0; t < 2; ++t) { if (mt < 2 && t == 1) continue;
                    const bf16x8 A = *(const LAS bf16x8*)(lds + ML_SB + (16 * mt + fr) * ML_TROW + (32 * t + 8 * fq) * 2);
                    const bf16x8 B = *(const LAS bf16x8*)(lds + ML_VT + (16 * wid + fr) * ML_TROW + (32 * t + 8 * fq) * 2);
                    acc[mt] = __builtin_amdgcn_mfma_f32_16x16x32_bf16(A, B, acc[mt], 0, 0, 0); }
            }
        }
        __syncthreads();
#pragma unroll
        for (int mt = 0; mt < 4; ++mt) { const f32x4 rd = *(const LAS f32x4*)(lds + ML_RDEN + (16 * mt + 4 * fq) * 4);
#pragma unroll
            for (int r = 0; r < 4; ++r) *(LAS float*)(lds + ML_H + (16 * mt + 4 * fq + r) * ML_HROW + (16 * wid + fr) * 4) = acc[mt][r] * rd[r]; }
        {
            const float decay = *(LAS float*)(lds + ML_GIW + 63 * 4);
            bf16x8 Vw[2];
#pragma unroll
            for (int t = 0; t < 2; ++t) { const u32x4 vr = *(const LAS u32x4*)(lds + ML_VT + (16 * wid + fr) * ML_TROW + (32 * t + 8 * fq) * 2);
                const f32x4 w0 = *(const LAS f32x4*)(lds + ML_GW + (32 * t + 8 * fq) * 4), w1 = *(const LAS f32x4*)(lds + ML_GW + (32 * t + 8 * fq + 4) * 4);
                u32x4 w; w.x = cvt_pk_bf16(bflo(vr[0]) * w0[0], bfhi(vr[0]) * w0[1]); w.y = cvt_pk_bf16(bflo(vr[1]) * w0[2], bfhi(vr[1]) * w0[3]);
                w.z = cvt_pk_bf16(bflo(vr[2]) * w1[0], bfhi(vr[2]) * w1[1]); w.w = cvt_pk_bf16(bflo(vr[3]) * w1[2], bfhi(vr[3]) * w1[3]); Vw[t] = __builtin_bit_cast(bf16x8, w); }
#pragma unroll
            for (int m = 0; m < 8; ++m) { Cst[m] = Cst[m] * decay;
#pragma unroll
                for (int t = 0; t < 2; ++t) { const bf16x8 A = *(const LAS bf16x8*)(lds + ML_KT + (16 * m + fr) * ML_TROW + (32 * t + 8 * fq) * 2);
                    Cst[m] = __builtin_amdgcn_mfma_f32_16x16x32_bf16(A, Vw[t], Cst[m], 0, 0, 0); } }
            const int nk = tid >> 2, np = tid & 3; float s = 0.f;
#pragma unroll
            for (int i = 0; i < 2; ++i) { const u32x4 kw = *(const LAS u32x4*)(lds + ML_KT + nk * ML_TROW + np * 32 + i * 16);
                const f32x4 w0 = *(const LAS f32x4*)(lds + ML_GW + (16 * np + 8 * i) * 4), w1 = *(const LAS f32x4*)(lds + ML_GW + (16 * np + 8 * i + 4) * 4);
                s += bflo(kw[0]) * w0[0] + bfhi(kw[0]) * w0[1] + bflo(kw[1]) * w0[2] + bfhi(kw[1]) * w0[3];
                s += bflo(kw[2]) * w1[0] + bfhi(kw[2]) * w1[1] + bflo(kw[3]) * w1[2] + bfhi(kw[3]) * w1[3]; }
            s += __shfl_xor(s, 1); s += __shfl_xor(s, 2);
            if (np == 0) { LAS float* nn = (LAS float*)(lds + ML_N + nk * 4); *nn = decay * (*nn) + s; }
        }
        __syncthreads();
        {
            float xv[16];
#pragma unroll
            for (int i = 0; i < 4; ++i) { const f32x4 hv = *(const LAS f32x4*)(lds + ML_H + el * ML_HROW + (16 * ep + 4 * i) * 4);
                const unsigned ow0 = oraw[i >> 1][2 * (i & 1)], ow1 = oraw[i >> 1][2 * (i & 1) + 1];
                xv[4 * i + 0] = hv[0] * sigmoidf_(bflo(ow0)); xv[4 * i + 1] = hv[1] * sigmoidf_(bfhi(ow0)); xv[4 * i + 2] = hv[2] * sigmoidf_(bflo(ow1)); xv[4 * i + 3] = hv[3] * sigmoidf_(bfhi(ow1)); }
            float sm = 0.f;
#pragma unroll
            for (int i = 0; i < 16; ++i) sm += xv[i];
#pragma unroll
            for (int o = 1; o < 8; o <<= 1) sm += __shfl_xor(sm, o);
            const float mean = sm * (1.f / 128.f); float sq = 0.f;
#pragma unroll
            for (int i = 0; i < 16; ++i) { xv[i] -= mean; sq += xv[i] * xv[i]; }
#pragma unroll
            for (int o = 1; o < 8; o <<= 1) sq += __shfl_xor(sq, o);
            const float rstd = rsqrtf(sq * (1.f / 128.f) + EPS);
            unsigned ow[8];
#pragma unroll
            for (int i = 0; i < 4; ++i) { const f32x4 g = *(const f32x4*)(p.hn_g + h * 128 + 16 * ep + 4 * i);
                const unsigned zw0 = zraw[i >> 1][2 * (i & 1)], zw1 = zraw[i >> 1][2 * (i & 1) + 1];
                const float z0 = bflo(zw0), z1 = bfhi(zw0), z2 = bflo(zw1), z3 = bfhi(zw1);
                ow[2 * i] = cvt_pk_bf16(xv[4 * i] * rstd * g[0] * z0 * sigmoidf_(z0), xv[4 * i + 1] * rstd * g[1] * z1 * sigmoidf_(z1));
                ow[2 * i + 1] = cvt_pk_bf16(xv[4 * i + 2] * rstd * g[2] * z2 * sigmoidf_(z2), xv[4 * i + 3] * rstd * g[3] * z3 * sigmoidf_(z3)); }
            bf16_t* op = p.MIX + erow * DM + 512 + h * 128 + 16 * ep;
            *(u32x4*)op = (u32x4){ow[0], ow[1], ow[2], ow[3]}; *(u32x4*)(op + 8) = (u32x4){ow[4], ow[5], ow[6], ow[7]};
        }
    }
}

__device__ void ml_naive(const Params& p, LAS unsigned char* lds) {
    const int bh = blockIdx.x; if (bh >= 64) return;
    const int b = bh >> 2, h = bh & 3, tid = threadIdx.x, lane = tid & 63;
    LAS float* qs = (LAS float*)lds; LAS float* ks = qs + 128; LAS float* vs = ks + 128; LAS float* part = vs + 128; LAS float* sc = part + 512; LAS float* qn = sc + 8;
    const int v = tid & 127, kg = tid >> 7;
    float C[32];
#pragma unroll
    for (int i = 0; i < 32; ++i) C[i] = 0.f;
    float nreg = 0.f, m = 0.f;
    float cw[4] = {0.f, 0.f, 0.f, 0.f}, cb = 0.f;
    if (tid < 256) { const int ch = (tid < 128) ? (h * 128 + tid) : (512 + h * 128 + (tid - 128));
#pragma unroll
        for (int j = 0; j < 4; ++j) cw[j] = p.conv_w[j * 1024 + ch];
        cb = p.conv_b[ch]; }
    for (int t = 0; t < SEQ; ++t) {
        const size_t row = (size_t)b * SEQ + t;
        if (tid < 256) {
            const int col = ((tid < 128) ? 2048 : 2560) + h * 128 + (tid & 127);
            float val = cb;
#pragma unroll
            for (int j = 0; j < 4; ++j) { const int tt = t - 3 + j; if (tt >= 0) val += cw[j] * bf2f(p.P[((size_t)b * SEQ + tt) * NP + col]); }
            if (tid < 128) qs[tid] = val; else ks[tid - 128] = val * 0.08838834764831845f;
        } else if (tid < 384) {
            vs[tid - 256] = bf2f(p.P[row * NP + 3072 + h * 128 + (tid - 256)]);
        } else if (tid == 384) {
            const float ig = p.G[row * 8 + h], fg = p.G[row * 8 + 4 + h];
            const float logf = -softplus_acc(-fg);
            const float mn = fmaxf(logf + m, ig);
            sc[0] = expf(ig - mn); sc[1] = expf(logf + m - mn); sc[2] = expf(-mn); m = mn;
        }
        __syncthreads();
        const float ip = sc[0], fp = sc[1];
        const float vv = vs[v]; float pa = 0.f;
#pragma unroll
        for (int i = 0; i < 32; ++i) { C[i] = fp * C[i] + ip * ks[kg * 32 + i] * vv; pa += qs[kg * 32 + i] * C[i]; }
        part[kg * 128 + v] = pa;
        if (tid < 128) { nreg = fp * nreg + ip * ks[tid]; float xq = qs[tid] * nreg; xq = wave_sum(xq); if (lane == 0) qn[tid >> 6] = xq; }
        __syncthreads();
        if (tid < 128) { const float num = (part[v] + part[128 + v]) + (part[256 + v] + part[384 + v]); const float den = qn[0] + qn[1];
            p.HRAW[row * 512 + h * 128 + v] = num / fmaxf(fabsf(den), sc[2]); }
        __syncthreads();
    }
}

__device__ void ml_post_naive(const Params& p) {
    const int tid = threadIdx.x, lane = tid & 63, wid = tid >> 6;
    const int gw = blockIdx.x * 8 + wid, NGW = gridDim.x * 8;
    for (int task = gw; task < NTOK * 4; task += NGW) {
        const size_t row = task >> 2; const int h = task & 3;
        float a[2];
#pragma unroll
        for (int i = 0; i < 2; ++i) { const int c = h * 128 + lane + 64 * i; a[i] = p.HRAW[row * 512 + c] * sigmoidf_(bf2f(p.P[row * NP + 3584 + c])); }
        const float mean = wave_sum(a[0] + a[1]) * (1.f / 128.f);
        const float d0 = a[0] - mean, d1 = a[1] - mean;
        const float var = wave_sum(d0 * d0 + d1 * d1) * (1.f / 128.f);
        const float rstd = rsqrtf(var + EPS);
#pragma unroll
        for (int i = 0; i < 2; ++i) { const int c = h * 128 + lane + 64 * i; const float z = bf2f(p.P[row * NP + 4096 + c]);
            const float y = (a[i] - mean) * rstd * p.hn_g[c] * z * sigmoidf_(z);
            p.MIX[row * DM + 512 + c] = f2bf(y); }
    }
}

__device__ __forceinline__ void phase_final(const Params& p) {
    const int gt = blockIdx.x * 512 + threadIdx.x, NGT = gridDim.x * 512;
    for (int it = gt; it < NTOK * 256; it += NGT) {
        const int row = it >> 8, c4 = (it & 255) * 4;
        const float rstd = rsqrtf(p.ROWSS[row] * (1.f / DM) + EPS);
        f32x4 hv = *(f32x4*)(p.out + (size_t)row * DM + c4); const f32x4 g = *(const f32x4*)(p.fin_g + c4);
        hv = hv * rstd * g;
        *(f32x4*)(p.out + (size_t)row * DM + c4) = hv;
    }
}

__global__ void __launch_bounds__(512, 2) hymba_fwd(Params p) {
    extern __shared__ __attribute__((aligned(16))) unsigned char smem[];
    LAS unsigned char* lds = (LAS unsigned char*)smem;
    cg::grid_group grid = cg::this_grid();
    phase_prep(p);
    grid.sync();
    {
        pg8::Gemm g{p.U, p.WIT, NTOK, NP, DM}; pg8::StaticOrder S; S.init(NTOK, NP, gridDim.x, blockIdx.x);
        pg8::EpiBf16 E{p.P, NP};
        pg8::gemm_phase(lds, g, S, E);
    }
    grid.sync();
#if FAST_ML
    if (blockIdx.x < 64) ml_fast(p, lds);
#else
    if (blockIdx.x < 64) ml_naive(p, lds);
#endif
#if FAST_ATT
    else att_fast(p, lds, 64, (int)gridDim.x - 64);
#else
    else att_naive(p, 64, (int)gridDim.x - 64);
#endif
    grid.sync();
#if !FAST_ML
    ml_post_naive(p);
    grid.sync();
#endif
    {
        pg8::Gemm g{p.MIX, p.WOT, NTOK, DM, DM}; pg8::StaticOrder S; S.init(NTOK, DM, gridDim.x, blockIdx.x);
        pg8::EpiOut E{p.out, p.x, p.ROWSS};
        pg8::gemm_phase(lds, g, S, E);
    }
    grid.sync();
    phase_final(p);
}

extern "C" void kernel_launch(void* const* d_in, const int* in_sizes, int n_in, void* d_out, int out_size, void* d_ws, size_t ws_size, hipStream_t stream) {
    static int grid_blocks = 0;
    if (!grid_blocks) {
        int dev = 0, cus = 0, per_cu = 0;
        (void)hipGetDevice(&dev);
        (void)hipDeviceGetAttribute(&cus, hipDeviceAttributeMultiprocessorCount, dev);
        (void)hipFuncSetAttribute((const void*)hymba_fwd, hipFuncAttributeMaxDynamicSharedMemorySize, LDS_BYTES);
        (void)hipOccupancyMaxActiveBlocksPerMultiprocessor(&per_cu, (const void*)hymba_fwd, 512, LDS_BYTES);
        (void)hipGetLastError();
        if (per_cu < 1) per_cu = 1;
        grid_blocks = cus;
        if (grid_blocks > 256) grid_blocks = 256;
    }
    Params p{};
    p.x = (const float*)d_in[0]; p.norm_g = (const float*)d_in[1]; p.w_in = (const float*)d_in[2]; p.b_ig = (const float*)d_in[3]; p.b_fg = (const float*)d_in[4];
    p.conv_w = (const float*)d_in[5]; p.conv_b = (const float*)d_in[6]; p.hn_g = (const float*)d_in[7]; p.w_out = (const float*)d_in[8]; p.fin_g = (const float*)d_in[9];
    p.out = (float*)d_out;
    unsigned char* ws = (unsigned char*)d_ws; size_t off = 0;
    p.U = (bf16_t*)(ws + off); p.HRAW = (float*)(ws + off); off += (size_t)NTOK * DM * 2;
    p.P = (bf16_t*)(ws + off); off += (size_t)NTOK * NP * 2;
    p.MIX = (bf16_t*)(ws + off); off += (size_t)NTOK * DM * 2;
    p.WIT = (bf16_t*)(ws + off); off += (size_t)NP * DM * 2;
    p.WOT = (bf16_t*)(ws + off); off += (size_t)DM * DM * 2;
    p.G = (float*)(ws + off); off += (size_t)NTOK * 8 * 4;
    p.MLG = (float*)(ws + off); off += (size_t)64 * 4 * SEQ * 4;
    p.ROWSS = (float*)(ws + off); off += (size_t)NTOK * 4;
    if (off > ws_size) { fprintf(stderr, "workspace too small: need %zu have %zu\n", off, ws_size); return; }
    void* args[] = {&p};
    hipError_t e = hipLaunchCooperativeKernel((const void*)hymba_fwd, dim3(grid_blocks), dim3(512), args, LDS_BYTES, stream);
    if (e != hipSuccess) fprintf(stderr, "cooperative launch failed: %s (grid %d)\n", hipGetErrorString(e), grid_blocks);
}
```

```cpp
#include <hip/hip_runtime.h>
#include <hip/hip_cooperative_groups.h>
#include <cstdio>
namespace cg = cooperative_groups;

#ifndef FAST_ATT
#define FAST_ATT 1
#endif
#ifndef FAST_ML
#define FAST_ML 1
#endif

#define LAS __attribute__((address_space(3)))
typedef unsigned short bf16_t;
typedef short bf16x8 __attribute__((ext_vector_type(8)));
typedef short s16x4 __attribute__((ext_vector_type(4)));
typedef float f32x4 __attribute__((ext_vector_type(4)));
typedef unsigned u32x4 __attribute__((ext_vector_type(4)));
typedef unsigned u32x2 __attribute__((ext_vector_type(2)));

constexpr int NTOK = 65536, DM = 1024, SEQ = 4096, NP = 4608, NIN = 4616;
constexpr int LDS_BYTES = 131072 + 8192;
constexpr float EPS = 1e-6f;
constexpr float LOG2E = 1.4426950408889634f, LN2 = 0.6931471805599453f;

struct Params {
    const float *x, *norm_g, *w_in, *b_ig, *b_fg, *conv_w, *conv_b, *hn_g, *w_out, *fin_g;
    float* out;
    bf16_t *U, *P, *MIX, *WIT, *WOT;
    float *G, *MLG, *ROWSS, *HRAW;
    unsigned long long* TS;
    bf16_t* HRAW16;
    unsigned* BAR; int never;
    int pad_;
};

__device__ __forceinline__ float bf2f(bf16_t b) { return __uint_as_float(((unsigned)b) << 16); }
__device__ __forceinline__ float bflo(unsigned w) { return __uint_as_float(w << 16); }
__device__ __forceinline__ float bfhi(unsigned w) { return __uint_as_float(w & 0xffff0000u); }
__device__ __forceinline__ unsigned cvt_pk_bf16(float lo, float hi) { unsigned r; asm volatile("v_cvt_pk_bf16_f32 %0, %1, %2" : "=v"(r) : "v"(lo), "v"(hi)); return r; }
__device__ __forceinline__ bf16_t f2bf(float f) { return (bf16_t)(cvt_pk_bf16(f, 0.f) & 0xffffu); }
template <int CTRL> __device__ __forceinline__ float dpp_mov(float v) { return __builtin_bit_cast(float, __builtin_amdgcn_update_dpp(0, __builtin_bit_cast(int, v), CTRL, 0xF, 0xF, true)); }
__device__ __forceinline__ float sum8(float v) { v += dpp_mov<0xB1>(v); v += dpp_mov<0x4E>(v); v += dpp_mov<0x141>(v); return v; }
__device__ __forceinline__ float sum16(float v) { v = sum8(v); v += dpp_mov<0x140>(v); return v; }
__device__ __forceinline__ float lane_of(float v, int l) { return __builtin_bit_cast(float, __builtin_amdgcn_readlane(__builtin_bit_cast(int, v), l)); }
__device__ __forceinline__ float wave_sum(float v) { v = sum16(v); return (lane_of(v, 0) + lane_of(v, 16)) + (lane_of(v, 32) + lane_of(v, 48)); }
__device__ __forceinline__ float sigmoidf_(float z) { return 1.f / (1.f + __expf(-z)); }


__device__ __forceinline__ void grid_barrier(unsigned* ctr, unsigned target) {
    asm volatile("s_waitcnt vmcnt(0)" ::: "memory");
    __syncthreads();
    if (threadIdx.x == 0) {
        __builtin_amdgcn_fence(__ATOMIC_RELEASE, "agent");
        asm volatile("s_waitcnt vmcnt(0)" ::: "memory");
        __hip_atomic_fetch_add(ctr, 1u, __ATOMIC_RELAXED, __HIP_MEMORY_SCOPE_AGENT);
        while (__hip_atomic_load(ctr, __ATOMIC_RELAXED, __HIP_MEMORY_SCOPE_AGENT) < target) __builtin_amdgcn_s_sleep(2);
        __builtin_amdgcn_fence(__ATOMIC_ACQUIRE, "agent");
        asm volatile("s_waitcnt vmcnt(0)" ::: "memory");
    }
    __syncthreads();
}

__device__ __forceinline__ void grid_arrive(unsigned* ctr) {
    asm volatile("s_waitcnt vmcnt(0)" ::: "memory");
    __syncthreads();
    if (threadIdx.x == 0) {
        __builtin_amdgcn_fence(__ATOMIC_RELEASE, "agent");
        asm volatile("s_waitcnt vmcnt(0)" ::: "memory");
        __hip_atomic_fetch_add(ctr, 1u, __ATOMIC_RELAXED, __HIP_MEMORY_SCOPE_AGENT);
    }
}

__device__ __forceinline__ void grid_wait(unsigned* ctr, unsigned target) {
    if (threadIdx.x == 0) {
        while (__hip_atomic_load(ctr, __ATOMIC_RELAXED, __HIP_MEMORY_SCOPE_AGENT) < target) __builtin_amdgcn_s_sleep(4);
        __builtin_amdgcn_fence(__ATOMIC_ACQUIRE, "agent");
        asm volatile("s_waitcnt vmcnt(0)" ::: "memory");
    }
    __syncthreads();
}

namespace pg8 {
constexpr int BM = 256, BK = 64, HALF = 128, HTB = HALF * BK * 2, NXCD = 8, WGM = 4;
__device__ __forceinline__ int lds_byte(int r, int c) { const int st = (r >> 4) * 2 + (c >> 5), rr = r & 15, cc = c & 31, ob = rr * 64 + cc * 2; return st * 1024 + (ob ^ (((ob >> 9) & 1) << 5)); }
__device__ __forceinline__ void stage_rc(int b, int& R, int& C) { const int st = b / 1024, sb = b % 1024, swz = sb ^ (((sb >> 9) & 1) << 5); R = (st >> 1) * 16 + swz / 64; C = (st & 1) * 32 + (swz % 64) / 2; }
__device__ __forceinline__ int perm32(int rho) { const int n = rho >> 4, i = rho & 15; return 8 * (i >> 2) + 4 * n + (i & 3); }
struct Unit { int pm, pn; };
struct Gemm { const bf16_t* A; const bf16_t* Bt; int M, N, K; };
struct StaticOrder {
    int nM, nN, nwg, G, c;
    int a0, a1, shift;
    __device__ void init(int M, int N, int G_, int c_) { nM = M / BM; nN = N / BM; nwg = nM * nN; G = G_; c = c_; a0 = 0; a1 = 1 << 30; shift = 0; }
    __device__ void cols(int a0_, int a1_, int shift_) { a0 = a0_; a1 = a1_; shift = shift_; }
    __device__ bool next(int i, Unit& u) const {
        const long L = (long)i * G + c; if (L >= nwg) return false;
        int wgid = (int)L; { const int q = nwg / NXCD, r = nwg % NXCD, xcd = wgid % NXCD, off = wgid / NXCD; wgid = (xcd < r ? xcd * (q + 1) : r * (q + 1) + (xcd - r) * q) + off; }
        const int nig = WGM * nN, gid = wgid / nig, fm = gid * WGM, gsz = (nM - fm) < WGM ? (nM - fm) : WGM;
        u.pm = fm + ((wgid % nig) % gsz); const int vn = (wgid % nig) / gsz; u.pn = vn < a1 ? vn + a0 : vn + shift; return true;
    }
};
template <bool NT> struct EpiBf16T {
    static constexpr bool PERM = true;
    bf16_t* O; int ldc;
    __device__ __forceinline__ void operator()(const f32x4 (&acc)[2][2][4][2], const Unit& u, int wr, int wc, int fr, int fq) const {
        const int row0 = u.pm * BM + wr * 64 + fr; const int col0 = u.pn * BM + wc * 32 + 8 * fq;
#pragma unroll
        for (int ai = 0; ai < 2; ++ai)
#pragma unroll
            for (int m = 0; m < 4; ++m) { bf16_t* rowp = O + (size_t)(row0 + ai * HALF + m * 16) * ldc + col0;
#pragma unroll
                for (int bj = 0; bj < 2; ++bj) { const f32x4 v0 = acc[ai][bj][m][0], v1 = acc[ai][bj][m][1];
                    u32x4 w; w.x = cvt_pk_bf16(v0[0], v0[1]); w.y = cvt_pk_bf16(v0[2], v0[3]); w.z = cvt_pk_bf16(v1[0], v1[1]); w.w = cvt_pk_bf16(v1[2], v1[3]);
                    if (NT) __builtin_nontemporal_store(w, (u32x4*)(rowp + bj * HALF)); else *(u32x4*)(rowp + bj * HALF) = w; } }
    }
};
struct EpiOut {
    static constexpr bool PERM = false;
    float* C; const float* X; float* rowss;
    __device__ __forceinline__ void operator()(const f32x4 (&acc)[2][2][4][2], const Unit& u, int wr, int wc, int fr, int fq) const {
        const int row0 = u.pm * BM + wr * 64 + fr, col0 = u.pn * BM + wc * 32 + 4 * fq;
#pragma unroll
        for (int ai = 0; ai < 2; ++ai)
#pragma unroll
            for (int m = 0; m < 4; ++m) { const int row = row0 + ai * HALF + m * 16; float* rowp = C + (size_t)row * DM + col0; const float* xp = X + (size_t)row * DM + col0; float ss = 0.f;
#pragma unroll
                for (int bj = 0; bj < 2; ++bj)
#pragma unroll
                    for (int n = 0; n < 2; ++n) { const f32x4 xv = *(const f32x4*)(xp + bj * HALF + n * 16); const f32x4 hv = xv + acc[ai][bj][m][n];
                        *(f32x4*)(rowp + bj * HALF + n * 16) = hv; ss += (hv[0] * hv[0] + hv[1] * hv[1]) + (hv[2] * hv[2] + hv[3] * hv[3]); }
                ss += __shfl_xor(ss, 16); ss += __shfl_xor(ss, 32);
                if (fq == 0) atomicAdd(rowss + row, ss); }
    }
};

struct PanelOrder {
    int c;
    __device__ bool next(int i, Unit& u) const { if (i >= 4) return false; u.pm = c; u.pn = i; return true; }
};
struct EpiOutFused {
    static constexpr bool PERM = false;
    float* C; const float* X; const float* gfin; LAS float* red;
    __device__ __forceinline__ void operator()(const f32x4 (&acc)[2][2][4][2], const Unit& u, int wr, int wc, int fr, int fq) {
        const int row0 = u.pm * BM + wr * 64 + fr, col0 = u.pn * BM + wc * 32 + 4 * fq;
#pragma unroll
        for (int ai = 0; ai < 2; ++ai)
#pragma unroll
            for (int m = 0; m < 4; ++m) { const int row = row0 + ai * HALF + m * 16; float* rowp = C + (size_t)row * DM + col0; const float* xp = X + (size_t)row * DM + col0; float ss = 0.f;
#pragma unroll
                for (int bj = 0; bj < 2; ++bj)
#pragma unroll
                    for (int n = 0; n < 2; ++n) { const f32x4 xv = *(const f32x4*)(xp + bj * HALF + n * 16); const f32x4 hv = xv + acc[ai][bj][m][n];
                        *(f32x4*)(rowp + bj * HALF + n * 16) = hv; ss += (hv[0] * hv[0] + hv[1] * hv[1]) + (hv[2] * hv[2] + hv[3] * hv[3]); }
                ss += __shfl_xor(ss, 16); ss += __shfl_xor(ss, 32);
                if (fq == 0) atomicAdd((float*)(red + ai * HALF + wr * 64 + m * 16 + fr), ss); }
    }
    __device__ __forceinline__ void finish(int pm) {
        const int tid = threadIdx.x;
        LAS float* rstd = red + 256;
        __syncthreads();
        if (tid < 256) rstd[tid] = rsqrtf(red[tid] * (1.f / DM) + EPS);
        __syncthreads();
        float* base = C + (size_t)pm * BM * DM;
#pragma unroll 4
        for (int i = 0; i < 128; ++i) { const int idx4 = i * 512 + tid, row = idx4 >> 8, c4 = (idx4 & 255) * 4;
            f32x4 v = *(f32x4*)(base + (size_t)row * DM + c4); const f32x4 g = *(const f32x4*)(gfin + c4);
            v = v * rstd[row] * g; *(f32x4*)(base + (size_t)row * DM + c4) = v; }
    }
};

template <class Epi, class Sched>
__device__ __forceinline__ void gemm_phase(LAS unsigned char* lds, const Gemm g, const Sched& S, Epi& E) {
    const int tid = threadIdx.x, wid = __builtin_amdgcn_readfirstlane(tid >> 6), lane = tid & 63, wr = wid >> 2, wc = wid & 3, fr = lane & 15, fq = lane >> 4;
    const int K = g.K, nt = K / BK;
    unsigned voffA[2], voffB[2];
#pragma unroll
    for (int i = 0; i < 2; ++i) { int R, C; stage_rc(tid * 16 + i * 8192, R, C); const int Rb = Epi::PERM ? ((R & ~31) + perm32(R & 31)) : R;
        voffA[i] = (unsigned)(R * K + C) * 2u; voffB[i] = (unsigned)(Rb * K + C) * 2u; }
    const size_t kstep = (size_t)(BK * 2);
    const size_t hstep = (size_t)HALF * K * 2;
    const size_t tstep = 2 * hstep;
    const unsigned ldsw = (unsigned)wid * 1024u;
    const int aoff = lds_byte(wr * 64 + fr, fq * 8), boff = lds_byte(wc * 32 + fr, fq * 8);
#define PG8_SA(b, h) (((b) * 2 + (h)) * HTB)
#define PG8_SB(b, h) ((4 + (b) * 2 + (h)) * HTB)
#define PG8_STAGE(bufoff, gbase, voff) do { _Pragma("unroll") for (int _i = 0; _i < 2; ++_i) \
        __builtin_amdgcn_global_load_lds((const unsigned*)((const char*)(gbase) + (voff)[_i]), (LAS unsigned*)(lds + (bufoff) + ldsw + _i * 8192), 16, 0, 0); } while (0)
#define PG8_LDA(dst, b, h) do { _Pragma("unroll") for (int m = 0; m < 4; ++m) _Pragma("unroll") for (int k = 0; k < 2; ++k) dst[m][k] = *(const LAS bf16x8*)(lds + PG8_SA(b, h) + aoff + m * 2048 + k * 1024); } while (0)
#define PG8_LDB(dst, b, h) do { _Pragma("unroll") for (int n = 0; n < 2; ++n) _Pragma("unroll") for (int k = 0; k < 2; ++k) dst[n][k] = *(const LAS bf16x8*)(lds + PG8_SB(b, h) + boff + n * 2048 + k * 1024); } while (0)
#define PG8_MMA(ai, bj, At, Bt) do { __builtin_amdgcn_s_setprio(1); _Pragma("unroll") for (int m = 0; m < 4; ++m) _Pragma("unroll") for (int n = 0; n < 2; ++n) _Pragma("unroll") for (int k = 0; k < 2; ++k) \
        acc[ai][bj][m][n] = __builtin_amdgcn_mfma_f32_16x16x32_bf16(Bt[n][k], At[m][k], acc[ai][bj][m][n], 0, 0, 0); __builtin_amdgcn_s_setprio(0); } while (0)
#define PG8_WAIT_V(n) asm volatile("s_waitcnt vmcnt(" #n ")" ::: "memory")
#define PG8_WAIT_L(n) asm volatile("s_waitcnt lgkmcnt(" #n ")" ::: "memory")
#define PG8_BAR __builtin_amdgcn_s_barrier()
#define PG8_SCHED __builtin_amdgcn_sched_barrier(0)
    Unit cur, nxt; int ui = 0;
    if (!S.next(0, cur)) return;
    f32x4 acc[2][2][4][2];
#pragma unroll
    for (int a = 0; a < 2; ++a)
#pragma unroll
        for (int b = 0; b < 2; ++b)
#pragma unroll
            for (int m = 0; m < 4; ++m)
#pragma unroll
                for (int n = 0; n < 2; ++n) acc[a][b][m][n] = (f32x4){0.f, 0.f, 0.f, 0.f};
    bf16x8 At[4][2], B0[2][2], B1[2][2];
    const char* cA = (const char*)g.A + (size_t)cur.pm * tstep; const char* cB = (const char*)g.Bt + (size_t)cur.pn * tstep;
    PG8_STAGE(PG8_SB(0, 0), cB, voffB); PG8_STAGE(PG8_SA(0, 0), cA, voffA); PG8_STAGE(PG8_SB(0, 1), cB + hstep, voffB); PG8_STAGE(PG8_SA(0, 1), cA + hstep, voffA);
    if (wr == 1) PG8_BAR;
    PG8_WAIT_V(4); PG8_BAR;
    PG8_STAGE(PG8_SB(1, 0), cB + kstep, voffB); PG8_STAGE(PG8_SA(1, 0), cA + kstep, voffA); PG8_STAGE(PG8_SB(1, 1), cB + hstep + kstep, voffB);
    PG8_WAIT_V(6); PG8_BAR;
    for (;;) {
        const bool has_next = S.next(ui + 1, nxt);
        const char* nA = has_next ? (const char*)g.A + (size_t)nxt.pm * tstep : cA; const char* nB = has_next ? (const char*)g.Bt + (size_t)nxt.pn * tstep : cB;
        for (int t = 0; t < nt; t += 2) {
            const bool last = (t == nt - 2);
            const char* a1 = cA + (size_t)(t + 1) * kstep;
            const char* a2 = last ? nA : cA + (size_t)(t + 2) * kstep; const char* b2 = last ? nB : cB + (size_t)(t + 2) * kstep;
            const char* a3 = a2 + kstep; const char* b3 = b2 + kstep;
            PG8_LDB(B0, 0, 0); PG8_SCHED; PG8_LDA(At, 0, 0); PG8_STAGE(PG8_SA(1, 1), a1 + hstep, voffA);
            PG8_WAIT_L(8); PG8_BAR; PG8_WAIT_L(0); PG8_MMA(0, 0, At, B0); PG8_BAR; PG8_SCHED;
            PG8_LDB(B1, 0, 1); PG8_STAGE(PG8_SB(0, 0), b2, voffB);
            PG8_BAR; PG8_WAIT_L(0); PG8_MMA(0, 1, At, B1); PG8_BAR;
            PG8_LDA(At, 0, 1); PG8_STAGE(PG8_SA(0, 0), a2, voffA);
            PG8_BAR; PG8_WAIT_L(0); PG8_MMA(1, 0, At, B0); PG8_BAR; PG8_SCHED;
            PG8_STAGE(PG8_SB(0, 1), b2 + hstep, voffB);
            PG8_WAIT_V(6); PG8_BAR; PG8_MMA(1, 1, At, B1); PG8_BAR;
            PG8_LDB(B0, 1, 0); PG8_SCHED; PG8_LDA(At, 1, 0); PG8_STAGE(PG8_SA(0, 1), a2 + hstep, voffA);
            PG8_WAIT_L(8); PG8_BAR; PG8_WAIT_L(0); PG8_MMA(0, 0, At, B0); PG8_BAR; PG8_SCHED;
            PG8_LDB(B1, 1, 1); PG8_STAGE(PG8_SB(1, 0), b3, voffB);
            PG8_BAR; PG8_WAIT_L(0); PG8_MMA(0, 1, At, B1); PG8_BAR;
            PG8_LDA(At, 1, 1); PG8_STAGE(PG8_SA(1, 0), a3, voffA);
            PG8_BAR; PG8_WAIT_L(0); PG8_MMA(1, 0, At, B0); PG8_BAR; PG8_SCHED;
            PG8_STAGE(PG8_SB(1, 1), b3 + hstep, voffB);
            PG8_WAIT_V(6); PG8_BAR; PG8_MMA(1, 1, At, B1); PG8_BAR;
        }
        E(acc, cur, wr, wc, fr, fq);
        if (!has_next) break;
#pragma unroll
        for (int a = 0; a < 2; ++a)
#pragma unroll
            for (int b = 0; b < 2; ++b)
#pragma unroll
                for (int m = 0; m < 4; ++m)
#pragma unroll
                    for (int n = 0; n < 2; ++n) acc[a][b][m][n] = (f32x4){0.f, 0.f, 0.f, 0.f};
        cur = nxt; cA = nA; cB = nB; ++ui;
    }
    PG8_WAIT_V(0);
    if (wr == 0) PG8_BAR;
    PG8_BAR;
#undef PG8_SA
#undef PG8_SB
#undef PG8_STAGE
#undef PG8_LDA
#undef PG8_LDB
#undef PG8_MMA
#undef PG8_WAIT_V
#undef PG8_WAIT_L
#undef PG8_BAR
#undef PG8_SCHED
}
}

__device__ __forceinline__ void phase_prep(const Params& p, LAS unsigned char* lds) {
    const int tid = threadIdx.x, lane = tid & 63, wid = tid >> 6;
    const int gt = blockIdx.x * 512 + tid, NGT = gridDim.x * 512;
    {
        LAS float* scr = (LAS float*)(lds + wid * 8448);
        const int gwv = blockIdx.x * 8 + wid, NGWV = gridDim.x * 8;
        constexpr int I_IN = (DM / 64) * (NP / 32), I_OUT = (DM / 64) * (DM / 32);
        for (int it = gwv; it < I_IN + I_OUT; it += NGWV) {
            const bool isin = it < I_IN; const int r = isin ? it : it - I_IN;
            const float* W = isin ? p.w_in : p.w_out; const int ldw = isin ? NIN : DM, nblk = isin ? NP / 32 : DM / 32;
            bf16_t* WT = isin ? p.WIT : p.WOT;
            const int kb = r / nblk, nb = r % nblk, k0 = 64 * kb, n0 = 32 * nb;
            const float sc = (isin && n0 < 512) ? 0.125f * LOG2E : 1.0f;
#pragma unroll 8
            for (int i = 0; i < 32; ++i) { const int kk = 2 * i + (lane >> 5); scr[kk * 33 + (lane & 31)] = W[(size_t)(k0 + kk) * ldw + n0 + (lane & 31)] * sc; }
            asm volatile("s_waitcnt lgkmcnt(0)" ::: "memory");
            const int cch = lane & 7;
#pragma unroll
            for (int j = 0; j < 4; ++j) { const int n = (lane >> 3) + 8 * j; const LAS float* s = scr + (8 * cch) * 33 + n;
                u32x4 o; o.x = cvt_pk_bf16(s[0 * 33], s[1 * 33]); o.y = cvt_pk_bf16(s[2 * 33], s[3 * 33]); o.z = cvt_pk_bf16(s[4 * 33], s[5 * 33]); o.w = cvt_pk_bf16(s[6 * 33], s[7 * 33]);
                *(u32x4*)(WT + (size_t)(n0 + n) * DM + k0 + 8 * cch) = o; }
            asm volatile("s_waitcnt lgkmcnt(0)" ::: "memory");
        }
        __syncthreads();
    }
    LAS float* wl = (LAS float*)lds;
    for (int r = tid; r < DM; r += 512) { const f32x4 a = *(const f32x4*)(p.w_in + (size_t)r * NIN + NP), bq = *(const f32x4*)(p.w_in + (size_t)r * NIN + NP + 4);
#pragma unroll
        for (int c = 0; c < 4; ++c) { wl[c * DM + r] = a[c]; wl[(4 + c) * DM + r] = bq[c]; } }
    __syncthreads();
    float gk[16], wg[16][8];
#pragma unroll
    for (int j = 0; j < 4; ++j) {
        const f32x4 g4 = *(const f32x4*)(p.norm_g + 4 * lane + 256 * j);
#pragma unroll
        for (int e = 0; e < 4; ++e) gk[j * 4 + e] = g4[e];
#pragma unroll
        for (int c = 0; c < 8; ++c) { const f32x4 t = *(const LAS f32x4*)(wl + c * DM + 4 * lane + 256 * j);
#pragma unroll
            for (int e = 0; e < 4; ++e) wg[j * 4 + e][c] = g4[e] * t[e]; } }
    const int gci = 4 * (lane >> 5) + 2 * ((lane >> 4) & 1) + ((lane >> 3) & 1);
    const float gbias = (gci < 4) ? p.b_ig[gci] : p.b_fg[gci - 4];
    const int gw = blockIdx.x * 8 + wid, NGW = gridDim.x * 8;
    f32x4 v[4], vn[4], vnn[4];
#pragma unroll
    for (int j = 0; j < 4; ++j) { v[j] = __builtin_nontemporal_load((const f32x4*)(p.x + (size_t)gw * DM + 4 * lane + 256 * j)); vn[j] = __builtin_nontemporal_load((const f32x4*)(p.x + (size_t)(gw + NGW) * DM + 4 * lane + 256 * j)); }
    for (int row = gw; row < NTOK; row += NGW) {
        const int nrow = row + 2 * NGW;
        if (nrow < NTOK) {
#pragma unroll
            for (int j = 0; j < 4; ++j) vnn[j] = __builtin_nontemporal_load((const f32x4*)(p.x + (size_t)nrow * DM + 4 * lane + 256 * j));
        }
        float ss = 0.f;
#pragma unroll
        for (int j = 0; j < 4; ++j) ss += (v[j][0] * v[j][0] + v[j][1] * v[j][1]) + (v[j][2] * v[j][2] + v[j][3] * v[j][3]);
        ss = wave_sum(ss);
        const float rstd = rsqrtf(ss * (1.f / DM) + EPS);
        float gacc[8];
#pragma unroll
        for (int c = 0; c < 8; ++c) gacc[c] = 0.f;
#pragma unroll
        for (int j = 0; j < 4; ++j) {
#pragma unroll
            for (int e = 0; e < 4; ++e) {
#pragma unroll
                for (int c = 0; c < 8; ++c) gacc[c] += v[j][e] * wg[j * 4 + e][c];
            }
            u32x2 w; w.x = cvt_pk_bf16(v[j][0] * rstd * gk[j * 4 + 0], v[j][1] * rstd * gk[j * 4 + 1]); w.y = cvt_pk_bf16(v[j][2] * rstd * gk[j * 4 + 2], v[j][3] * rstd * gk[j * 4 + 3]);
            *(u32x2*)(p.U + (size_t)row * DM + 4 * lane + 256 * j) = w;
        }
        float f4[4], f2[2], f1;
        { const bool up = (lane & 32) != 0;
#pragma unroll
          for (int c = 0; c < 4; ++c) { const float keep = up ? gacc[c + 4] : gacc[c], send = up ? gacc[c] : gacc[c + 4]; f4[c] = keep + __shfl_xor(send, 32); } }
        { const bool up = (lane & 16) != 0;
#pragma unroll
          for (int c = 0; c < 2; ++c) { const float keep = up ? f4[c + 2] : f4[c], send = up ? f4[c] : f4[c + 2]; f2[c] = keep + __shfl_xor(send, 16); } }
        { const bool up = (lane & 8) != 0; const float keep = up ? f2[1] : f2[0], send = up ? f2[0] : f2[1]; f1 = keep + __shfl_xor(send, 8); }
        f1 = sum8(f1);
        if ((lane & 7) == 0) { const int c = 4 * (lane >> 5) + 2 * ((lane >> 4) & 1) + ((lane >> 3) & 1);
            p.G[(size_t)row * 8 + c] = f1 * rstd + gbias; }
#pragma unroll
        for (int j = 0; j < 4; ++j) { v[j] = vn[j]; vn[j] = vnn[j]; }
    }
}

__device__ __forceinline__ float softplus_acc(float z) { return fmaxf(z, 0.f) + log1pf(expf(-fabsf(z))); }

__device__ void att_naive(const Params& p, int nb_first, int nb_count) {
    const int tix = ((int)blockIdx.x - nb_first) * 512 + (int)threadIdx.x, nthr = nb_count * 512;
    for (int idx = tix; idx < 16 * 8 * SEQ; idx += nthr) {
        const int t = idx & (SEQ - 1), h = (idx >> 12) & 7, b = idx >> 15;
        const size_t row = (size_t)b * SEQ + t;
        const bf16_t* qp = p.P + row * NP + h * 64;
        float q[64], acc[64];
#pragma unroll
        for (int c = 0; c < 8; ++c) { const u32x4 w = *(const u32x4*)(qp + 8 * c);
#pragma unroll
            for (int e = 0; e < 4; ++e) { q[8 * c + 2 * e] = bflo(w[e]); q[8 * c + 2 * e + 1] = bfhi(w[e]); } }
#pragma unroll
        for (int d = 0; d < 64; ++d) acc[d] = 0.f;
        float carry = 0.f;
        for (int s = t - 1; s >= 0; --s) {
            const bf16_t* kp = p.P + ((size_t)b * SEQ + s) * NP + 512 + h * 64;
            const bf16_t* vp = kp + 512;
            float z = 0.f;
#pragma unroll
            for (int c = 0; c < 8; ++c) { const u32x4 w = *(const u32x4*)(kp + 8 * c);
#pragma unroll
                for (int e = 0; e < 4; ++e) { z += q[8 * c + 2 * e] * bflo(w[e]); z += q[8 * c + 2 * e + 1] * bfhi(w[e]); } }
            const float sp = softplus_acc(z);
            const float wgt = expf(z - sp + carry);
#pragma unroll
            for (int c = 0; c < 8; ++c) { const u32x4 w = *(const u32x4*)(vp + 8 * c);
#pragma unroll
                for (int e = 0; e < 4; ++e) { acc[8 * c + 2 * e] += wgt * bflo(w[e]); acc[8 * c + 2 * e + 1] += wgt * bfhi(w[e]); } }
            carry -= sp;
            if (carry < -104.f) break;
        }
        const bf16_t* zp = p.P + row * NP + 1536 + h * 64;
        bf16_t* op = p.MIX + row * DM + h * 64;
#pragma unroll
        for (int c = 0; c < 8; ++c) { const u32x4 w = *(const u32x4*)(zp + 8 * c); u32x4 o;
#pragma unroll
            for (int e = 0; e < 4; ++e) { const float z0 = bflo(w[e]), z1 = bfhi(w[e]);
                o[e] = cvt_pk_bf16(acc[8 * c + 2 * e] * z0 * sigmoidf_(z0), acc[8 * c + 2 * e + 1] * z1 * sigmoidf_(z1)); }
            *(u32x4*)(op + 8 * c) = o; }
    }
}

constexpr int AT_ROWB = 144, AT_TILE = 64 * AT_ROWB;
__device__ __forceinline__ s16x4 tr_read4(LAS unsigned char* p) { return __builtin_amdgcn_ds_read_tr16_b64_v4i16((LAS s16x4*)p); }

__device__ void att_fast(const Params& p, LAS unsigned char* lds, int nb_first, int nb_count) {
    const int tid = threadIdx.x, wid = __builtin_amdgcn_readfirstlane(tid >> 6), lane = tid & 63, fr = lane & 15, fq = lane >> 4;
    constexpr int AT_T2 = 128 * AT_ROWB;
    LAS int* flags = (LAS int*)(lds + 4 * AT_T2);
    bf16x8 T0, T1, TONE;
#pragma unroll
    for (int jj = 0; jj < 8; ++jj) { const int j = 16 * (jj >> 2) + 4 * fq + (jj & 3); T0[jj] = (j > fr) ? (short)0x3F80 : (short)0; T1[jj] = (j > 16 + fr) ? (short)0x3F80 : (short)0; TONE[jj] = (short)0x3F80; }
    const int srow = tid >> 3, sch = tid & 7;
    constexpr int NU = 16 * 8 * 32;
    bf16x8 Qn[2]; u32x4 kn[2], vn[2];
#define ATT_DECODE(uu, qb_, h_, b_) const int qb_ = (((uu) >> 3) ^ ((uu) >> 8)) & 31, h_ = (uu) & 7, b_ = (uu) >> 8
#define ATT_FETCH(uu) do { ATT_DECODE(uu, qb2, h2, b2); const size_t rq2 = (size_t)b2 * SEQ + qb2 * 128 + 16 * wid + fr; \
        _Pragma("unroll") for (int t = 0; t < 2; ++t) Qn[t] = *(const bf16x8*)(p.P + rq2 * NP + h2 * 64 + 32 * t + 8 * fq); \
        const bf16_t* kv2 = p.P + ((size_t)b2 * SEQ + srow + 128 * qb2) * NP + 512 + h2 * 64 + sch * 8; \
        _Pragma("unroll") for (int s2 = 0; s2 < 2; ++s2) { kn[s2] = *(const u32x4*)(kv2 + (size_t)(64 * s2) * NP); vn[s2] = *(const u32x4*)(kv2 + (size_t)(64 * s2) * NP + 512); } } while (0)
    int u = (int)blockIdx.x - nb_first;
    if (u < NU) ATT_FETCH(u);
    for (; u < NU; u += nb_count) {
        ATT_DECODE(u, qb, h, b);
        const int qw0 = qb * 128 + 16 * wid, tq = qw0 + fr;
        const size_t rowq = (size_t)b * SEQ + tq;
        bf16x8 Qf[2];
#pragma unroll
        for (int t = 0; t < 2; ++t) Qf[t] = Qn[t];
        f32x4 oacc[4];
#pragma unroll
        for (int d = 0; d < 4; ++d) oacc[d] = (f32x4){0.f, 0.f, 0.f, 0.f};
        float carry = 0.f;
        const int ktop = qb;
        const bf16_t* kvbase = p.P + ((size_t)b * SEQ + srow) * NP + 512 + h * 64 + sch * 8;
        u32x4 kreg[2], vreg[2];
#pragma unroll
        for (int s2 = 0; s2 < 2; ++s2) { *(LAS u32x4*)(lds + (srow + 64 * s2) * AT_ROWB + sch * 16) = kn[s2]; *(LAS u32x4*)(lds + AT_T2 + (srow + 64 * s2) * AT_ROWB + sch * 16) = vn[s2]; }
        u32x2 zw4[4];
#pragma unroll
        for (int d = 0; d < 4; ++d) zw4[d] = *(const u32x2*)(p.P + rowq * NP + 1536 + h * 64 + 16 * d + 4 * fq);
        if (u + nb_count < NU) ATT_FETCH(u + nb_count);
        __syncthreads();
        for (int it = 0;; ++it) {
            const int kt = ktop - it, buf = it & 1;
            if (kt > 0) {
#pragma unroll
                for (int s2 = 0; s2 < 2; ++s2) { kreg[s2] = *(const u32x4*)(kvbase + (size_t)(128 * (kt - 1) + 64 * s2) * NP); vreg[s2] = *(const u32x4*)(kvbase + (size_t)(128 * (kt - 1) + 64 * s2) * NP + 512); }
            }
#pragma unroll 1
          for (int sub = 1; sub >= 0; --sub) {
            const int k0 = 128 * kt + 64 * sub;
            const bool wdone = __all(carry < -150.1f);
            if (!wdone && k0 <= qw0 + 15) {
                LAS unsigned char* Kb = lds + buf * 2 * AT_T2 + sub * 64 * AT_ROWB; LAS unsigned char* Vb = Kb + AT_T2;
                f32x4 z[4];
#pragma unroll
                for (int k4 = 0; k4 < 4; ++k4) { z[k4] = (f32x4){0.f, 0.f, 0.f, 0.f};
#pragma unroll
                    for (int t = 0; t < 2; ++t) { const bf16x8 A = *(const LAS bf16x8*)(Kb + (16 * k4 + fr) * AT_ROWB + (32 * t + 8 * fq) * 2);
                        z[k4] = __builtin_amdgcn_mfma_f32_16x16x32_bf16(A, Qf[t], z[k4], 0, 0, 0); } }
                float lneg[4][4], lpos[4][4];
#pragma unroll
                for (int k4 = 0; k4 < 4; ++k4)
#pragma unroll
                    for (int r = 0; r < 4; ++r) { const float a = z[k4][r]; const bool strict = (k0 + 16 * k4 + 4 * fq + r) < tq;
                        const float e = __builtin_amdgcn_exp2f(-fabsf(a));
                        const float sp = fmaxf(a, 0.f) + __builtin_amdgcn_logf(1.f + e);
                        lneg[k4][r] = strict ? -sp : 0.f; lpos[k4][r] = a - sp; }
                bf16x8 Lf[2];
#pragma unroll
                for (int t = 0; t < 2; ++t) { u32x4 w; w.x = cvt_pk_bf16(lneg[2 * t][0], lneg[2 * t][1]); w.y = cvt_pk_bf16(lneg[2 * t][2], lneg[2 * t][3]);
                    w.z = cvt_pk_bf16(lneg[2 * t + 1][0], lneg[2 * t + 1][1]); w.w = cvt_pk_bf16(lneg[2 * t + 1][2], lneg[2 * t + 1][3]); Lf[t] = __builtin_bit_cast(bf16x8, w); }
                const f32x4 c4 = (f32x4){carry, carry, carry, carry};
                f32x4 E[4];
                E[0] = __builtin_amdgcn_mfma_f32_16x16x32_bf16(T0, Lf[0], c4, 0, 0, 0); E[0] = __builtin_amdgcn_mfma_f32_16x16x32_bf16(TONE, Lf[1], E[0], 0, 0, 0);
                E[1] = __builtin_amdgcn_mfma_f32_16x16x32_bf16(T1, Lf[0], c4, 0, 0, 0); E[1] = __builtin_amdgcn_mfma_f32_16x16x32_bf16(TONE, Lf[1], E[1], 0, 0, 0);
                E[2] = __builtin_amdgcn_mfma_f32_16x16x32_bf16(T0, Lf[1], c4, 0, 0, 0);
                E[3] = __builtin_amdgcn_mfma_f32_16x16x32_bf16(T1, Lf[1], c4, 0, 0, 0);
                float aw[4][4];
#pragma unroll
                for (int k4 = 0; k4 < 4; ++k4)
#pragma unroll
                    for (int r = 0; r < 4; ++r) { const bool strict = (k0 + 16 * k4 + 4 * fq + r) < tq;
                        const float ex = __builtin_amdgcn_exp2f(lpos[k4][r] + E[k4][r]); aw[k4][r] = strict ? ex : 0.f; }
                {
                    f32x4 tot4 = __builtin_amdgcn_mfma_f32_16x16x32_bf16(TONE, Lf[0], c4, 0, 0, 0); tot4 = __builtin_amdgcn_mfma_f32_16x16x32_bf16(TONE, Lf[1], tot4, 0, 0, 0);
                    carry = tot4[0]; }
                bf16x8 Af[2];
#pragma unroll
                for (int t = 0; t < 2; ++t) { u32x4 w; w.x = cvt_pk_bf16(aw[2 * t][0], aw[2 * t][1]); w.y = cvt_pk_bf16(aw[2 * t][2], aw[2 * t][3]);
                    w.z = cvt_pk_bf16(aw[2 * t + 1][0], aw[2 * t + 1][1]); w.w = cvt_pk_bf16(aw[2 * t + 1][2], aw[2 * t + 1][3]); Af[t] = __builtin_bit_cast(bf16x8, w); }
#pragma unroll
                for (int d = 0; d < 4; ++d)
#pragma unroll
                    for (int t = 0; t < 2; ++t) { LAS unsigned char* a0 = Vb + (32 * t + 4 * fq + (fr >> 2)) * AT_ROWB + (16 * d + 4 * (fr & 3)) * 2;
                        const s16x4 lo = tr_read4(a0), hi = tr_read4(a0 + 16 * AT_ROWB);
                        const bf16x8 Vf = __builtin_shufflevector(lo, hi, 0, 1, 2, 3, 4, 5, 6, 7);
                        oacc[d] = __builtin_amdgcn_mfma_f32_16x16x32_bf16(Vf, Af[t], oacc[d], 0, 0, 0); }
            }
          }
            const bool wdone2 = __all(carry < -150.1f);
            if (lane == 0) flags[buf * 8 + wid] = wdone2 ? 1 : 0;
            if (kt > 0) {
#pragma unroll
                for (int s2 = 0; s2 < 2; ++s2) { *(LAS u32x4*)(lds + (buf ^ 1) * 2 * AT_T2 + (srow + 64 * s2) * AT_ROWB + sch * 16) = kreg[s2]; *(LAS u32x4*)(lds + (buf ^ 1) * 2 * AT_T2 + AT_T2 + (srow + 64 * s2) * AT_ROWB + sch * 16) = vreg[s2]; }
            }
            __syncthreads();
            if (kt == 0) break;
            int alld = 1;
#pragma unroll
            for (int w = 0; w < 8; ++w) alld &= flags[buf * 8 + w];
            if (alld) break;
        }
#pragma unroll
        for (int d = 0; d < 4; ++d) { const int col = h * 64 + 16 * d + 4 * fq;
            const u32x2 zw = zw4[d];
            const float z0 = bflo(zw.x), z1 = bfhi(zw.x), z2 = bflo(zw.y), z3 = bfhi(zw.y);
            u32x2 o; o.x = cvt_pk_bf16(oacc[d][0] * z0 * sigmoidf_(z0), oacc[d][1] * z1 * sigmoidf_(z1)); o.y = cvt_pk_bf16(oacc[d][2] * z2 * sigmoidf_(z2), oacc[d][3] * z3 * sigmoidf_(z3));
            *(u32x2*)(p.MIX + rowq * DM + col) = o; }
    }
#undef ATT_DECODE
#undef ATT_FETCH
}

constexpr int ML_QROW = 272, ML_TROW = 144, ML_HROW = 528;
constexpr int ML_Q = 0, ML_K = 17408, ML_KT = 34816, ML_VT = 53248, ML_SB = 71680, ML_H = 80896;
constexpr int ML_GA = 114688, ML_GM = ML_GA + 256, ML_GIW = ML_GM + 256, ML_GEN = ML_GIW + 256, ML_GW = ML_GEN + 256, ML_N = ML_GW + 256, ML_RDEN = ML_N + 512, ML_SCAN = ML_RDEN + 256;

__device__ void ml_fast(const Params& p, LAS unsigned char* lds) {
    const int bh = blockIdx.x; if (bh >= 64) return;
    const int b = bh >> 2, h = bh & 3, tid = threadIdx.x, lane = tid & 63, wid = __builtin_amdgcn_readfirstlane(tid >> 6), fr = lane & 15, fq = lane >> 4;
    float* mlg = p.MLG + (size_t)bh * 4 * SEQ;
    {
        LAS float* scan = (LAS float*)(lds + ML_SCAN);
        float a_[8], pm_[8], bc_[8];
#pragma unroll
        for (int i = 0; i < 8; ++i) {
            const int c = wid + 8 * i; const size_t tok = (size_t)b * SEQ + 64 * c + lane;
            const float ig = p.G[tok * 8 + h], fg = p.G[tok * 8 + 4 + h];
            float bc = -softplus_acc(-fg);
#pragma unroll
            for (int o = 1; o < 64; o <<= 1) { const float t = __shfl_up(bc, o); if (lane >= o) bc += t; }
            const float a = ig - bc; float pm = a;
#pragma unroll
            for (int o = 1; o < 64; o <<= 1) { const float t = __shfl_up(pm, o); if (lane >= o) pm = fmaxf(pm, t); }
            a_[i] = a; pm_[i] = pm; bc_[i] = bc;
            if (lane == 63) { scan[c] = bc; scan[64 + c] = pm; }
        }
        __syncthreads();
        if (tid == 0) { float m = 0.f; for (int c = 0; c < 64; ++c) { scan[128 + c] = m; m = scan[c] + fmaxf(m, scan[64 + c]); } }
        __syncthreads();
#pragma unroll
        for (int i = 0; i < 8; ++i) {
            const int c = wid + 8 * i; const float mc = scan[128 + c]; const float M = fmaxf(mc, pm_[i]);
            const int o = 64 * c + lane;
            mlg[o] = a_[i]; mlg[SEQ + o] = M; mlg[2 * SEQ + o] = expf(mc - M); mlg[3 * SEQ + o] = expf(-(bc_[i] + M));
        }
        if (tid < 128) *(LAS float*)(lds + ML_N + tid * 4) = 0.f;
        __syncthreads();
    }
    const int isK = tid >> 8, rg = (tid >> 4) & 15, cg = tid & 15;
    float cw[4][8], cb[8];
    {
        const int ch = isK * 512 + h * 128 + 8 * cg; const float sc = isK ? 0.08838834764831845f : 1.0f;
#pragma unroll
        for (int e = 0; e < 8; ++e) { cb[e] = p.conv_b[ch + e] * sc;
#pragma unroll
            for (int j = 0; j < 4; ++j) cw[j][e] = p.conv_w[j * 1024 + ch + e] * sc; }
    }
    const int vrg = tid >> 5, vcg = tid & 31;
    const int el = tid >> 3, ep = tid & 7;
    const bf16_t* qkbase = p.P + (size_t)b * SEQ * NP + (isK ? 2560 : 2048) + h * 128 + 8 * cg;
    const bf16_t* vbase = p.P + (size_t)b * SEQ * NP + 3072 + h * 128 + 4 * vcg;
    f32x4 Cst[8];
#pragma unroll
    for (int m = 0; m < 8; ++m) Cst[m] = (f32x4){0.f, 0.f, 0.f, 0.f};
    u32x4 raw[7]; u32x2 vraw[4]; float graw = 0.f;
#pragma unroll
    for (int i = 0; i < 7; ++i) { const int r = 4 * rg - 3 + i; raw[i] = (r >= 0) ? *(const u32x4*)(qkbase + (size_t)r * NP) : (u32x4){0u, 0u, 0u, 0u}; }
#pragma unroll
    for (int i = 0; i < 4; ++i) vraw[i] = *(const u32x2*)(vbase + (size_t)(4 * vrg + i) * NP);
    if (tid < 256) graw = mlg[(tid >> 6) * SEQ + (tid & 63)];

    for (int c = 0; c < 64; ++c) {
        {
            float o[4][8];
#pragma unroll
            for (int i = 0; i < 4; ++i)
#pragma unroll
                for (int e = 0; e < 8; ++e) o[i][e] = cb[e];
#pragma unroll
            for (int rr = 0; rr < 7; ++rr) {
                float in[8];
#pragma unroll
                for (int e = 0; e < 4; ++e) { in[2 * e] = bflo(raw[rr][e]); in[2 * e + 1] = bfhi(raw[rr][e]); }
#pragma unroll
                for (int i = 0; i < 4; ++i) { const int j = rr - i; if (j >= 0 && j < 4) {
#pragma unroll
                    for (int e = 0; e < 8; ++e) o[i][e] += cw[j][e] * in[e]; } }
            }
            unsigned pk[4][4];
#pragma unroll
            for (int i = 0; i < 4; ++i)
#pragma unroll
                for (int e = 0; e < 4; ++e) pk[i][e] = cvt_pk_bf16(o[i][2 * e], o[i][2 * e + 1]);
            LAS unsigned char* nat = lds + (isK ? ML_K : ML_Q);
#pragma unroll
            for (int i = 0; i < 4; ++i) *(LAS u32x4*)(nat + (4 * rg + i) * ML_QROW + cg * 16) = (u32x4){pk[i][0], pk[i][1], pk[i][2], pk[i][3]};
            if (isK) {
#pragma unroll
                for (int e = 0; e < 8; ++e) { const int w = e >> 1; unsigned w0, w1;
                    if (e & 1) { w0 = (pk[0][w] >> 16) | (pk[1][w] & 0xffff0000u); w1 = (pk[2][w] >> 16) | (pk[3][w] & 0xffff0000u); }
                    else { w0 = (pk[0][w] & 0xffffu) | (pk[1][w] << 16); w1 = (pk[2][w] & 0xffffu) | (pk[3][w] << 16); }
                    *(LAS u32x2*)(lds + ML_KT + (8 * cg + e) * ML_TROW + 8 * rg) = (u32x2){w0, w1}; }
            }
#pragma unroll
            for (int e = 0; e < 4; ++e) { unsigned w0, w1;
                if (e & 1) { w0 = (vraw[0][e >> 1] >> 16) | (vraw[1][e >> 1] & 0xffff0000u); w1 = (vraw[2][e >> 1] >> 16) | (vraw[3][e >> 1] & 0xffff0000u); }
                else { w0 = (vraw[0][e >> 1] & 0xffffu) | (vraw[1][e >> 1] << 16); w1 = (vraw[2][e >> 1] & 0xffffu) | (vraw[3][e >> 1] << 16); }
                *(LAS u32x2*)(lds + ML_VT + (4 * vcg + e) * ML_TROW + 8 * vrg) = (u32x2){w0, w1}; }
            if (tid < 256) *(LAS float*)(lds + ML_GA + tid * 4) = graw;
        }
        if (c < 63) {
            const int r0 = 64 * (c + 1);
#pragma unroll
            for (int i = 0; i < 7; ++i) raw[i] = *(const u32x4*)(qkbase + (size_t)(r0 + 4 * rg - 3 + i) * NP);
#pragma unroll
            for (int i = 0; i < 4; ++i) vraw[i] = *(const u32x2*)(vbase + (size_t)(r0 + 4 * vrg + i) * NP);
            if (tid < 256) graw = mlg[(tid >> 6) * SEQ + r0 + (tid & 63)];
        }
        const size_t erow = (size_t)b * SEQ + 64 * c + el;
        u32x4 oraw[2], zraw[2];
#pragma unroll
        for (int i = 0; i < 2; ++i) { oraw[i] = *(const u32x4*)(p.P + erow * NP + 3584 + h * 128 + 16 * ep + 8 * i); zraw[i] = *(const u32x4*)(p.P + erow * NP + 4096 + h * 128 + 16 * ep + 8 * i); }
        __syncthreads();
        if (tid < 64) *(LAS float*)(lds + ML_GW + tid * 4) = __expf(*(LAS float*)(lds + ML_GA + tid * 4) - *(LAS float*)(lds + ML_GM + 63 * 4));
        {
            const int lt = wid >> 1;
#pragma unroll
            for (int si = 0; si < 2; ++si) {
                const int st = 2 * (wid & 1) + si;
                f32x4 acc = (f32x4){0.f, 0.f, 0.f, 0.f};
                float val[4] = {0.f, 0.f, 0.f, 0.f};
                if (st <= lt) {
#pragma unroll
                    for (int t = 0; t < 4; ++t) { const bf16x8 A = *(const LAS bf16x8*)(lds + ML_Q + (16 * lt + fr) * ML_QROW + (32 * t + 8 * fq) * 2);
                        const bf16x8 B = *(const LAS bf16x8*)(lds + ML_K + (16 * st + fr) * ML_QROW + (32 * t + 8 * fq) * 2);
                        acc = __builtin_amdgcn_mfma_f32_16x16x32_bf16(A, B, acc, 0, 0, 0); }
                    const float as = *(LAS float*)(lds + ML_GA + (16 * st + fr) * 4);
                    const f32x4 Ml = *(const LAS f32x4*)(lds + ML_GM + (16 * lt + 4 * fq) * 4);
#pragma unroll
                    for (int r = 0; r < 4; ++r) val[r] = (16 * st + fr <= 16 * lt + 4 * fq + r) ? acc[r] * __expf(as - Ml[r]) : 0.f;
                }
#pragma unroll
                for (int r = 0; r < 4; ++r) *(LAS bf16_t*)(lds + ML_SB + (16 * lt + 4 * fq + r) * ML_TROW + (16 * st + fr) * 2) = f2bf(val[r]);
            }
        }
        __syncthreads();
        {
            const u32x4 sw = *(const LAS u32x4*)(lds + ML_SB + el * ML_TROW + ep * 16);
            float rs = 0.f;
#pragma unroll
            for (int e = 0; e < 4; ++e) rs += bflo(sw[e]) + bfhi(sw[e]);
            float qn = 0.f;
#pragma unroll
            for (int i = 0; i < 2; ++i) { const u32x4 qw = *(const LAS u32x4*)(lds + ML_Q + el * ML_QROW + ep * 32 + i * 16);
                const f32x4 n0 = *(const LAS f32x4*)(lds + ML_N + (16 * ep + 8 * i) * 4), n1 = *(const LAS f32x4*)(lds + ML_N + (16 * ep + 8 * i + 4) * 4);
                qn += bflo(qw[0]) * n0[0] + bfhi(qw[0]) * n0[1] + bflo(qw[1]) * n0[2] + bfhi(qw[1]) * n0[3];
                qn += bflo(qw[2]) * n1[0] + bfhi(qw[2]) * n1[1] + bflo(qw[3]) * n1[2] + bfhi(qw[3]) * n1[3]; }
#pragma unroll
            for (int o = 1; o < 8; o <<= 1) { rs += __shfl_xor(rs, o); qn += __shfl_xor(qn, o); }
            if (ep == 0) { const float den = *(LAS float*)(lds + ML_GIW + el * 4) * qn + rs;
                *(LAS float*)(lds + ML_RDEN + el * 4) = 1.f / fmaxf(fabsf(den), *(LAS float*)(lds + ML_GEN + el * 4)); }
        }
        f32x4 acc[4];
        {
            bf16x8 Cb[4];
#pragma unroll
            for (int t = 0; t < 4; ++t) { u32x4 w; w.x = cvt_pk_bf16(Cst[2 * t][0], Cst[2 * t][1]); w.y = cvt_pk_bf16(Cst[2 * t][2], Cst[2 * t][3]);
                w.z = cvt_pk_bf16(Cst[2 * t + 1][0], Cst[2 * t + 1][1]); w.w = cvt_pk_bf16(Cst[2 * t + 1][2], Cst[2 * t + 1][3]); Cb[t] = __builtin_bit_cast(bf16x8, w); }
#pragma unroll
            for (int mt = 0; mt < 4; ++mt) {
                acc[mt] = (f32x4){0.f, 0.f, 0.f, 0.f};
#pragma unroll
                for (int t = 0; t < 4; ++t) { LAS unsigned char* qa = lds + ML_Q + (16 * mt + fr) * ML_QROW + (32 * t + 4 * fq) * 2;
                    const u32x2 lo = *(const LAS u32x2*)qa, hi = *(const LAS u32x2*)(qa + 32);
                    const bf16x8 A = __builtin_bit_cast(bf16x8, (u32x4){lo.x, lo.y, hi.x, hi.y});
                    acc[mt] = __builtin_amdgcn_mfma_f32_16x16x32_bf16(A, Cb[t], acc[mt], 0, 0, 0); }
                const f32x4 iw = *(const LAS f32x4*)(lds + ML_GIW + (16 * mt + 4 * fq) * 4);
                acc[mt] = acc[mt] * iw;
#pragma unroll
                for (int t = 0; t < 2; ++t) { if (mt < 2 && t == 1) continue;
                    const bf16x8 A = *(const LAS bf16x8*)(lds + ML_SB + (16 * mt + fr) * ML_TROW + (32 * t + 8 * fq) * 2);
                    const bf16x8 B = *(const LAS bf16x8*)(lds + ML_VT + (16 * wid + fr) * ML_TROW + (32 * t + 8 * fq) * 2);
                    acc[mt] = __builtin_amdgcn_mfma_f32_16x16x32_bf16(A, B, acc[mt], 0, 0, 0); }
            }
        }
        __syncthreads();
#pragma unroll
        for (int mt = 0; mt < 4; ++mt) { const f32x4 rd = *(const LAS f32x4*)(lds + ML_RDEN + (16 * mt + 4 * fq) * 4);
#pragma unroll
            for (int r = 0; r < 4; ++r) *(LAS float*)(lds + ML_H + (16 * mt + 4 * fq + r) * ML_HROW + (16 * wid + fr) * 4) = acc[mt][r] * rd[r]; }
        {
            const float decay = *(LAS float*)(lds + ML_GIW + 63 * 4);
            bf16x8 Vw[2];
#pragma unroll
            for (int t = 0; t < 2; ++t) { const u32x4 vr = *(const LAS u32x4*)(lds + ML_VT + (16 * wid + fr) * ML_TROW + (32 * t + 8 * fq) * 2);
                const f32x4 w0 = *(const LAS f32x4*)(lds + ML_GW + (32 * t + 8 * fq) * 4), w1 = *(const LAS f32x4*)(lds + ML_GW + (32 * t + 8 * fq + 4) * 4);
                u32x4 w; w.x = cvt_pk_bf16(bflo(vr[0]) * w0[0], bfhi(vr[0]) * w0[1]); w.y = cvt_pk_bf16(bflo(vr[1]) * w0[2], bfhi(vr[1]) * w0[3]);
                w.z = cvt_pk_bf16(bflo(vr[2]) * w1[0], bfhi(vr[2]) * w1[1]); w.w = cvt_pk_bf16(bflo(vr[3]) * w1[2], bfhi(vr[3]) * w1[3]); Vw[t] = __builtin_bit_cast(bf16x8, w); }
#pragma unroll
            for (int m = 0; m < 8; ++m) { Cst[m] = Cst[m] * decay;
#pragma unroll
                for (int t = 0; t < 2; ++t) { const bf16x8 A = *(const LAS bf16x8*)(lds + ML_KT + (16 * m + fr) * ML_TROW + (32 * t + 8 * fq) * 2);
                    Cst[m] = __builtin_amdgcn_mfma_f32_16x16x32_bf16(A, Vw[t], Cst[m], 0, 0, 0); } }
            const int nk = tid >> 2, np = tid & 3; float s = 0.f;
#pragma unroll
            for (int i = 0; i < 2; ++i) { const u32x4 kw = *(const LAS u32x4*)(lds + ML_KT + nk * ML_TROW + np * 32 + i * 16);
                const f32x4 w0 = *(const LAS f32x4*)(lds + ML_GW + (16 * np + 8 * i) * 4), w1 = *(const LAS f32x4*)(lds + ML_GW + (16 * np + 8 * i + 4) * 4);
                s += bflo(kw[0]) * w0[0] + bfhi(kw[0]) * w0[1] + bflo(kw[1]) * w0[2] + bfhi(kw[1]) * w0[3];
                s += bflo(kw[2]) * w1[0] + bfhi(kw[2]) * w1[1] + bflo(kw[3]) * w1[2] + bfhi(kw[3]) * w1[3]; }
            s += __shfl_xor(s, 1); s += __shfl_xor(s, 2);
            if (np == 0) { LAS float* nn = (LAS float*)(lds + ML_N + nk * 4); *nn = decay * (*nn) + s; }
        }
        __syncthreads();
        {
            float xv[16];
#pragma unroll
            for (int i = 0; i < 4; ++i) { const f32x4 hv = *(const LAS f32x4*)(lds + ML_H + el * ML_HROW + (16 * ep + 4 * i) * 4);
                const unsigned ow0 = oraw[i >> 1][2 * (i & 1)], ow1 = oraw[i >> 1][2 * (i & 1) + 1];
                xv[4 * i + 0] = hv[0] * sigmoidf_(bflo(ow0)); xv[4 * i + 1] = hv[1] * sigmoidf_(bfhi(ow0)); xv[4 * i + 2] = hv[2] * sigmoidf_(bflo(ow1)); xv[4 * i + 3] = hv[3] * sigmoidf_(bfhi(ow1)); }
            float sm = 0.f;
#pragma unroll
            for (int i = 0; i < 16; ++i) sm += xv[i];
#pragma unroll
            for (int o = 1; o < 8; o <<= 1) sm += __shfl_xor(sm, o);
            const float mean = sm * (1.f / 128.f); float sq = 0.f;
#pragma unroll
            for (int i = 0; i < 16; ++i) { xv[i] -= mean; sq += xv[i] * xv[i]; }
#pragma unroll
            for (int o = 1; o < 8; o <<= 1) sq += __shfl_xor(sq, o);
            const float rstd = rsqrtf(sq * (1.f / 128.f) + EPS);
            unsigned ow[8];
#pragma unroll
            for (int i = 0; i < 4; ++i) { const f32x4 g = *(const f32x4*)(p.hn_g + h * 128 + 16 * ep + 4 * i);
                const unsigned zw0 = zraw[i >> 1][2 * (i & 1)], zw1 = zraw[i >> 1][2 * (i & 1) + 1];
                const float z0 = bflo(zw0), z1 = bfhi(zw0), z2 = bflo(zw1), z3 = bfhi(zw1);
                ow[2 * i] = cvt_pk_bf16(xv[4 * i] * rstd * g[0] * z0 * sigmoidf_(z0), xv[4 * i + 1] * rstd * g[1] * z1 * sigmoidf_(z1));
                ow[2 * i + 1] = cvt_pk_bf16(xv[4 * i + 2] * rstd * g[2] * z2 * sigmoidf_(z2), xv[4 * i + 3] * rstd * g[3] * z3 * sigmoidf_(z3)); }
            bf16_t* op = p.MIX + erow * DM + 512 + h * 128 + 16 * ep;
            *(u32x4*)op = (u32x4){ow[0], ow[1], ow[2], ow[3]}; *(u32x4*)(op + 8) = (u32x4){ow[4], ow[5], ow[6], ow[7]};
        }
    }
}

constexpr int M2_SET = 53248, M2_Q = 0, M2_K = 17408, M2_V = 34816, M2_G = 52224;
constexpr int M2_SB = 2 * M2_SET, M2_GW = M2_SB + 9216, M2_N = M2_GW + 256, M2_RDEN = M2_N + 512, M2_SCAN = M2_RDEN + 256;
constexpr int M2_ROW = 272, M2_SROW = 144;
constexpr int M2_H = M2_SCAN;

__device__ __forceinline__ void ml2_stage(LAS unsigned char* set, const u32x4 (&raw)[7], const u32x4 (&vraw)[2], float graw, const float (&cw)[4][8], const float (&cb)[8],
                                          int isK, int rg, int cg, int tid) {
    float o[4][8];
#pragma unroll
    for (int i = 0; i < 4; ++i)
#pragma unroll
        for (int e = 0; e < 8; ++e) o[i][e] = cb[e];
#pragma unroll
    for (int rr = 0; rr < 7; ++rr) {
        float in[8];
#pragma unroll
        for (int e = 0; e < 4; ++e) { in[2 * e] = bflo(raw[rr][e]); in[2 * e + 1] = bfhi(raw[rr][e]); }
#pragma unroll
        for (int i = 0; i < 4; ++i) { const int j = rr - i; if (j >= 0 && j < 4) {
#pragma unroll
            for (int e = 0; e < 8; ++e) o[i][e] += cw[j][e] * in[e]; } }
    }
    LAS unsigned char* nat = set + (isK ? M2_K : M2_Q);
#pragma unroll
    for (int i = 0; i < 4; ++i) { u32x4 w; w.x = cvt_pk_bf16(o[i][0], o[i][1]); w.y = cvt_pk_bf16(o[i][2], o[i][3]); w.z = cvt_pk_bf16(o[i][4], o[i][5]); w.w = cvt_pk_bf16(o[i][6], o[i][7]);
        *(LAS u32x4*)(nat + (4 * rg + i) * M2_ROW + cg * 16) = w; }
    LAS unsigned char* vp = set + M2_V + (tid >> 3) * M2_ROW + (tid & 7) * 32;
    *(LAS u32x4*)vp = vraw[0]; *(LAS u32x4*)(vp + 16) = vraw[1];
    if (tid < 256) *(LAS float*)(set + M2_G + tid * 4) = graw;
}

__device__ void ml_fast2(const Params& p, LAS unsigned char* lds) {
    const int bh = blockIdx.x; if (bh >= 64) return;
    const int b = bh >> 2, h = bh & 3, tid = threadIdx.x, lane = tid & 63, wid = __builtin_amdgcn_readfirstlane(tid >> 6), fr = lane & 15, fq = lane >> 4;
    float* mlg = p.MLG + (size_t)bh * 4 * SEQ;
    {
        LAS float* scan = (LAS float*)(lds + M2_SCAN);
        float a_[8], pm_[8], bc_[8];
#pragma unroll
        for (int i = 0; i < 8; ++i) {
            const int c = wid + 8 * i; const size_t tok = (size_t)b * SEQ + 64 * c + lane;
            const float ig = p.G[tok * 8 + h], fg = p.G[tok * 8 + 4 + h];
            float bc = -softplus_acc(-fg);
#pragma unroll
            for (int o = 1; o < 64; o <<= 1) { const float t = __shfl_up(bc, o); if (lane >= o) bc += t; }
            const float a = ig - bc; float pm = a;
#pragma unroll
            for (int o = 1; o < 64; o <<= 1) { const float t = __shfl_up(pm, o); if (lane >= o) pm = fmaxf(pm, t); }
            a_[i] = a; pm_[i] = pm; bc_[i] = bc;
            if (lane == 63) { scan[c] = bc; scan[64 + c] = pm; }
        }
        __syncthreads();
        if (tid == 0) { float m = 0.f; for (int c = 0; c < 64; ++c) { scan[128 + c] = m; m = scan[c] + fmaxf(m, scan[64 + c]); } }
        __syncthreads();
#pragma unroll
        for (int i = 0; i < 8; ++i) {
            const int c = wid + 8 * i; const float mc = scan[128 + c]; const float M = fmaxf(mc, pm_[i]);
            const int o = 64 * c + lane;
            mlg[o] = a_[i]; mlg[SEQ + o] = M; mlg[2 * SEQ + o] = expf(mc - M); mlg[3 * SEQ + o] = expf(-(bc_[i] + M));
        }
        if (tid < 128) *(LAS float*)(lds + M2_N + tid * 4) = 0.f;
        __syncthreads();
    }
    const int isK = tid >> 8, rg = (tid >> 4) & 15, cg = tid & 15;
    float cw[4][8], cb[8];
    {
        const int ch = isK * 512 + h * 128 + 8 * cg; const float sc = isK ? 0.08838834764831845f : 1.0f;
#pragma unroll
        for (int e = 0; e < 8; ++e) { cb[e] = p.conv_b[ch + e] * sc;
#pragma unroll
            for (int j = 0; j < 4; ++j) cw[j][e] = p.conv_w[j * 1024 + ch + e] * sc; }
    }
    const int el = tid >> 3, ep = tid & 7;
    const bf16_t* qkbase = p.P + (size_t)b * SEQ * NP + (isK ? 2560 : 2048) + h * 128 + 8 * cg;
    const bf16_t* vbase = p.P + (size_t)b * SEQ * NP + 3072 + h * 128 + (size_t)(tid >> 3) * NP + (tid & 7) * 16;
    f32x4 Cst[8];
#pragma unroll
    for (int m = 0; m < 8; ++m) Cst[m] = (f32x4){0.f, 0.f, 0.f, 0.f};
    f32x4 nacc = (f32x4){0.f, 0.f, 0.f, 0.f};
    u32x4 raw[7], vraw[2]; float graw = 0.f;
#pragma unroll
    for (int i = 0; i < 7; ++i) { const int r = 4 * rg - 3 + i; raw[i] = (r >= 0) ? *(const u32x4*)(qkbase + (size_t)r * NP) : (u32x4){0u, 0u, 0u, 0u}; }
    vraw[0] = *(const u32x4*)vbase; vraw[1] = *(const u32x4*)(vbase + 8);
    if (tid < 256) graw = mlg[(tid >> 6) * SEQ + (tid & 63)];
    ml2_stage(lds, raw, vraw, graw, cw, cb, isK, rg, cg, tid);
#pragma unroll
    for (int i = 0; i < 7; ++i) raw[i] = *(const u32x4*)(qkbase + (size_t)(64 + 4 * rg - 3 + i) * NP);
    vraw[0] = *(const u32x4*)(vbase + (size_t)64 * NP); vraw[1] = *(const u32x4*)(vbase + (size_t)64 * NP + 8);
    if (tid < 256) graw = mlg[(tid >> 6) * SEQ + 64 + (tid & 63)];

    for (int c = 0; c < 64; ++c) {
        LAS unsigned char* set = lds + (c & 1) * M2_SET;
        __syncthreads();
        if (c > 0) {
            const u32x4 h0 = *(const LAS u32x4*)(lds + M2_H + el * M2_ROW + ep * 32), h1 = *(const LAS u32x4*)(lds + M2_H + el * M2_ROW + ep * 32 + 16);
            bf16_t* hg = p.HRAW16 + ((size_t)b * SEQ + 64 * (c - 1) + el) * 512 + h * 128 + ep * 16;
            __builtin_nontemporal_store(h0, (u32x4*)hg); __builtin_nontemporal_store(h1, (u32x4*)(hg + 8)); }
        if (tid < 64) *(LAS float*)(lds + M2_GW + tid * 4) = __expf(*(LAS float*)(set + M2_G + tid * 4) - *(LAS float*)(set + M2_G + 256 + 63 * 4));
        {
            const int lt = wid >> 1;
#pragma unroll
            for (int si = 0; si < 2; ++si) {
                const int st = 2 * (wid & 1) + si;
                f32x4 acc = (f32x4){0.f, 0.f, 0.f, 0.f};
                float val[4] = {0.f, 0.f, 0.f, 0.f};
                if (st <= lt) {
#pragma unroll
                    for (int t = 0; t < 4; ++t) { const bf16x8 A = *(const LAS bf16x8*)(set + M2_Q + (16 * lt + fr) * M2_ROW + (32 * t + 8 * fq) * 2);
                        const bf16x8 B = *(const LAS bf16x8*)(set + M2_K + (16 * st + fr) * M2_ROW + (32 * t + 8 * fq) * 2);
                        acc = __builtin_amdgcn_mfma_f32_16x16x32_bf16(A, B, acc, 0, 0, 0); }
                    const float as = *(LAS float*)(set + M2_G + (16 * st + fr) * 4);
                    const f32x4 Ml = *(const LAS f32x4*)(set + M2_G + 256 + (16 * lt + 4 * fq) * 4);
#pragma unroll
                    for (int r = 0; r < 4; ++r) val[r] = (16 * st + fr <= 16 * lt + 4 * fq + r) ? acc[r] * __expf(as - Ml[r]) : 0.f;
                }
#pragma unroll
                for (int r = 0; r < 4; ++r) *(LAS bf16_t*)(lds + M2_SB + (16 * lt + 4 * fq + r) * M2_SROW + (16 * st + fr) * 2) = f2bf(val[r]);
            }
        }
        float qn = 0.f;
#pragma unroll
        for (int i = 0; i < 2; ++i) { const u32x4 qw = *(const LAS u32x4*)(set + M2_Q + el * M2_ROW + ep * 32 + i * 16);
            const f32x4 n0 = *(const LAS f32x4*)(lds + M2_N + (16 * ep + 8 * i) * 4), n1 = *(const LAS f32x4*)(lds + M2_N + (16 * ep + 8 * i + 4) * 4);
            qn += bflo(qw[0]) * n0[0] + bfhi(qw[0]) * n0[1] + bflo(qw[1]) * n0[2] + bfhi(qw[1]) * n0[3];
            qn += bflo(qw[2]) * n1[0] + bfhi(qw[2]) * n1[1] + bflo(qw[3]) * n1[2] + bfhi(qw[3]) * n1[3]; }
        __syncthreads();
        {
            const u32x4 sw = *(const LAS u32x4*)(lds + M2_SB + el * M2_SROW + ep * 16);
            float rs = 0.f;
#pragma unroll
            for (int e = 0; e < 4; ++e) rs += bflo(sw[e]) + bfhi(sw[e]);
            rs = sum8(rs); qn = sum8(qn);
            if (ep == 0) { const float den = *(LAS float*)(set + M2_G + 512 + el * 4) * qn + rs;
                *(LAS float*)(lds + M2_RDEN + el * 4) = 1.f / fmaxf(fabsf(den), *(LAS float*)(set + M2_G + 768 + el * 4)); }
        }
        if (c < 63) {
            ml2_stage(lds + ((c + 1) & 1) * M2_SET, raw, vraw, graw, cw, cb, isK, rg, cg, tid);
            if (c < 62) {
                const int r0 = 64 * (c + 2);
#pragma unroll
                for (int i = 0; i < 7; ++i) raw[i] = *(const u32x4*)(qkbase + (size_t)(r0 + 4 * rg - 3 + i) * NP);
                vraw[0] = *(const u32x4*)(vbase + (size_t)r0 * NP); vraw[1] = *(const u32x4*)(vbase + (size_t)r0 * NP + 8);
                if (tid < 256) graw = mlg[(tid >> 6) * SEQ + r0 + (tid & 63)];
            }
        }
        bf16x8 Vf[2];
#pragma unroll
        for (int t = 0; t < 2; ++t) { LAS unsigned char* va = set + M2_V + (32 * t + 8 * fq + (fr >> 2)) * M2_ROW + (16 * wid + 4 * (fr & 3)) * 2;
            const s16x4 lo = tr_read4(va), hi = tr_read4(va + 4 * M2_ROW); Vf[t] = __builtin_shufflevector(lo, hi, 0, 1, 2, 3, 4, 5, 6, 7); }
        f32x4 acc[4];
        {
            bf16x8 Cb[4];
#pragma unroll
            for (int t = 0; t < 4; ++t) { u32x4 w; w.x = cvt_pk_bf16(Cst[2 * t][0], Cst[2 * t][1]); w.y = cvt_pk_bf16(Cst[2 * t][2], Cst[2 * t][3]);
                w.z = cvt_pk_bf16(Cst[2 * t + 1][0], Cst[2 * t + 1][1]); w.w = cvt_pk_bf16(Cst[2 * t + 1][2], Cst[2 * t + 1][3]); Cb[t] = __builtin_bit_cast(bf16x8, w); }
#pragma unroll
            for (int mt = 0; mt < 4; ++mt) {
                acc[mt] = (f32x4){0.f, 0.f, 0.f, 0.f};
#pragma unroll
                for (int t = 0; t < 4; ++t) { LAS unsigned char* qa = set + M2_Q + (16 * mt + fr) * M2_ROW + (32 * t + 4 * fq) * 2;
                    const u32x2 lo = *(const LAS u32x2*)qa, hi = *(const LAS u32x2*)(qa + 32);
                    const bf16x8 A = __builtin_bit_cast(bf16x8, (u32x4){lo.x, lo.y, hi.x, hi.y});
                    acc[mt] = __builtin_amdgcn_mfma_f32_16x16x32_bf16(A, Cb[t], acc[mt], 0, 0, 0); }
                const f32x4 iw = *(const LAS f32x4*)(set + M2_G + 512 + (16 * mt + 4 * fq) * 4);
                acc[mt] = acc[mt] * iw;
#pragma unroll
                for (int t = 0; t < 2; ++t) { if (mt < 2 && t == 1) continue;
                    const bf16x8 A = *(const LAS bf16x8*)(lds + M2_SB + (16 * mt + fr) * M2_SROW + (32 * t + 8 * fq) * 2);
                    acc[mt] = __builtin_amdgcn_mfma_f32_16x16x32_bf16(A, Vf[t], acc[mt], 0, 0, 0); }
            }
        }
        __syncthreads();
        {
            LAS unsigned char* hp = lds + M2_H + (16 * wid + fr) * 2;
#pragma unroll
            for (int mt = 0; mt < 4; ++mt) { const f32x4 rd = *(const LAS f32x4*)(lds + M2_RDEN + (16 * mt + 4 * fq) * 4);
#pragma unroll
                for (int r = 0; r < 4; ++r) *(LAS bf16_t*)(hp + (16 * mt + 4 * fq + r) * M2_ROW) = f2bf(acc[mt][r] * rd[r]); }
        }
        {
            const float decay = *(LAS float*)(set + M2_G + 512 + 63 * 4);
            bf16x8 Vw[2], Wf[2];
#pragma unroll
            for (int t = 0; t < 2; ++t) { const u32x4 vr = __builtin_bit_cast(u32x4, Vf[t]);
                const f32x4 w0 = *(const LAS f32x4*)(lds + M2_GW + (32 * t + 8 * fq) * 4), w1 = *(const LAS f32x4*)(lds + M2_GW + (32 * t + 8 * fq + 4) * 4);
                u32x4 w; w.x = cvt_pk_bf16(bflo(vr[0]) * w0[0], bfhi(vr[0]) * w0[1]); w.y = cvt_pk_bf16(bflo(vr[1]) * w0[2], bfhi(vr[1]) * w0[3]);
                w.z = cvt_pk_bf16(bflo(vr[2]) * w1[0], bfhi(vr[2]) * w1[1]); w.w = cvt_pk_bf16(bflo(vr[3]) * w1[2], bfhi(vr[3]) * w1[3]); Vw[t] = __builtin_bit_cast(bf16x8, w);
                u32x4 ww; ww.x = cvt_pk_bf16(w0[0], w0[1]); ww.y = cvt_pk_bf16(w0[2], w0[3]); ww.z = cvt_pk_bf16(w1[0], w1[1]); ww.w = cvt_pk_bf16(w1[2], w1[3]);
                if (fr != 0) ww = (u32x4){0u, 0u, 0u, 0u};
                Wf[t] = __builtin_bit_cast(bf16x8, ww); }
            nacc = nacc * decay;
#pragma unroll
            for (int m = 0; m < 8; ++m) { Cst[m] = Cst[m] * decay;
#pragma unroll
                for (int t = 0; t < 2; ++t) { LAS unsigned char* ka = set + M2_K + (32 * t + 8 * fq + (fr >> 2)) * M2_ROW + (16 * m + 4 * (fr & 3)) * 2;
                    const s16x4 lo = tr_read4(ka), hi = tr_read4(ka + 4 * M2_ROW);
                    const bf16x8 A = __builtin_shufflevector(lo, hi, 0, 1, 2, 3, 4, 5, 6, 7);
                    Cst[m] = __builtin_amdgcn_mfma_f32_16x16x32_bf16(A, Vw[t], Cst[m], 0, 0, 0);
                    if (m == wid) nacc = __builtin_amdgcn_mfma_f32_16x16x32_bf16(A, Wf[t], nacc, 0, 0, 0); } }
            if (fr == 0) *(LAS f32x4*)(lds + M2_N + (16 * wid + 4 * fq) * 4) = nacc;
        }
    }
    __syncthreads();
    {   const u32x4 h0 = *(const LAS u32x4*)(lds + M2_H + el * M2_ROW + ep * 32), h1 = *(const LAS u32x4*)(lds + M2_H + el * M2_ROW + ep * 32 + 16);
        bf16_t* hg = p.HRAW16 + ((size_t)b * SEQ + 64 * 63 + el) * 512 + h * 128 + ep * 16;
        __builtin_nontemporal_store(h0, (u32x4*)hg); __builtin_nontemporal_store(h1, (u32x4*)(hg + 8)); }
}

__device__ __forceinline__ void ml_post(const Params& p) {
    const int tid = threadIdx.x, lane = tid & 63, wid = tid >> 6;
    const int gw = blockIdx.x * 256 + wid * 32, NGW = 1;
    const int c0 = (lane >> 4) * 128 + 8 * (lane & 15);
    float g[8];
#pragma unroll
    for (int i = 0; i < 8; ++i) g[i] = p.hn_g[c0 + i];
    for (int row0 = gw; row0 < gw + 32; row0 += 4 * NGW) {
        u32x4 hv4[4], ov4[4], zv4[4];
#pragma unroll
        for (int q = 0; q < 4; ++q) { const size_t row = (size_t)row0 + (size_t)q * NGW;
            hv4[q] = __builtin_nontemporal_load((const u32x4*)(p.HRAW16 + row * 512 + c0)); ov4[q] = __builtin_nontemporal_load((const u32x4*)(p.P + row * NP + 3584 + c0)); zv4[q] = __builtin_nontemporal_load((const u32x4*)(p.P + row * NP + 4096 + c0)); }
#pragma unroll
        for (int q = 0; q < 4; ++q) {
            const size_t row = (size_t)row0 + (size_t)q * NGW; const u32x4 hv = hv4[q], ov = ov4[q], zv = zv4[q];
            float x[8]; float sm = 0.f;
#pragma unroll
            for (int e = 0; e < 4; ++e) { x[2 * e] = bflo(hv[e]) * sigmoidf_(bflo(ov[e])); x[2 * e + 1] = bfhi(hv[e]) * sigmoidf_(bfhi(ov[e])); sm += x[2 * e] + x[2 * e + 1]; }
            sm = sum16(sm);
            const float mean = sm * (1.f / 128.f); float sq = 0.f;
#pragma unroll
            for (int i = 0; i < 8; ++i) { x[i] -= mean; sq += x[i] * x[i]; }
            sq = sum16(sq);
            const float rstd = rsqrtf(sq * (1.f / 128.f) + EPS);
            u32x4 ow;
#pragma unroll
            for (int e = 0; e < 4; ++e) { const float z0 = bflo(zv[e]), z1 = bfhi(zv[e]);
                ow[e] = cvt_pk_bf16(x[2 * e] * rstd * g[2 * e] * z0 * sigmoidf_(z0), x[2 * e + 1] * rstd * g[2 * e + 1] * z1 * sigmoidf_(z1)); }
            *(u32x4*)(p.MIX + row * DM + 512 + c0) = ow;
        }
    }
}

__device__ __forceinline__ void phase_final(const Params& p) {
    const int tid = threadIdx.x, lane = tid & 63, wid = tid >> 6;
    const int base = blockIdx.x * 256 + wid * 32;
    f32x4 g[4];
#pragma unroll
    for (int j = 0; j < 4; ++j) g[j] = *(const f32x4*)(p.fin_g + 4 * lane + 256 * j);
    f32x4 v[2][4], vn[2][4]; u32x2 d[2][4], dn[2][4];
#pragma unroll
    for (int q = 0; q < 2; ++q)
#pragma unroll
        for (int j = 0; j < 4; ++j) { const size_t r = (size_t)base + q; v[q][j] = __builtin_nontemporal_load((const f32x4*)(p.x + r * DM + 4 * lane + 256 * j)); d[q][j] = __builtin_nontemporal_load((const u32x2*)(p.U + r * DM + 4 * lane + 256 * j)); }
    for (int it = 0; it < 16; ++it) {
        const int row0 = base + 2 * it;
        if (it < 15) {
#pragma unroll
            for (int q = 0; q < 2; ++q)
#pragma unroll
                for (int j = 0; j < 4; ++j) { const size_t r = (size_t)row0 + 2 + q; vn[q][j] = __builtin_nontemporal_load((const f32x4*)(p.x + r * DM + 4 * lane + 256 * j)); dn[q][j] = __builtin_nontemporal_load((const u32x2*)(p.U + r * DM + 4 * lane + 256 * j)); }
        }
#pragma unroll
        for (int q = 0; q < 2; ++q) {
            const size_t row = (size_t)row0 + q;
            float ss = 0.f;
#pragma unroll
            for (int j = 0; j < 4; ++j) { v[q][j][0] += bflo(d[q][j].x); v[q][j][1] += bfhi(d[q][j].x); v[q][j][2] += bflo(d[q][j].y); v[q][j][3] += bfhi(d[q][j].y);
                ss += (v[q][j][0] * v[q][j][0] + v[q][j][1] * v[q][j][1]) + (v[q][j][2] * v[q][j][2] + v[q][j][3] * v[q][j][3]); }
            ss = wave_sum(ss);
            const float rstd = rsqrtf(ss * (1.f / DM) + EPS);
#pragma unroll
            for (int j = 0; j < 4; ++j) __builtin_nontemporal_store(v[q][j] * rstd * g[j], (f32x4*)(p.out + row * DM + 4 * lane + 256 * j));
        }
#pragma unroll
        for (int q = 0; q < 2; ++q)
#pragma unroll
            for (int j = 0; j < 4; ++j) { v[q][j] = vn[q][j]; d[q][j] = dn[q][j]; }
    }
}

#ifndef PROBE_SEL
#define PROBE_SEL 0
#endif
#define STAMP(i) do { if (PROBE_SEL && threadIdx.x == 0 && (blockIdx.x == 0 || blockIdx.x == 64)) p.TS[(blockIdx.x ? 32 : 0) + (i)] = __builtin_amdgcn_s_memrealtime(); } while (0)
__global__ void __launch_bounds__(512, 2) hymba_fwd(Params p) {
    extern __shared__ __attribute__((aligned(16))) unsigned char smem[];
    LAS unsigned char* lds = (LAS unsigned char*)smem;
    cg::grid_group grid = cg::this_grid();
    STAMP(0);
    if (p.never) grid.sync();
    phase_prep(p, lds);
    STAMP(1);
    grid_barrier(p.BAR, gridDim.x * 1u);
    STAMP(2);
    {
        pg8::Gemm g{p.U, p.WIT, NTOK, NP, DM}; pg8::StaticOrder S; S.init(NTOK, 6 * 256, gridDim.x, blockIdx.x); S.cols(8, 1 << 30, 0);
        pg8::EpiBf16T<true> E{p.P, NP};
        pg8::gemm_phase(lds, g, S, E);
    }
    STAMP(3);
    if (blockIdx.x < 64) {
        grid_barrier(p.BAR + 8, gridDim.x);
    STAMP(4);
        ml_fast2(p, lds);
        grid_wait(p.BAR + 16, gridDim.x - 64u);
    } else {
        grid_arrive(p.BAR + 8);
        {
            pg8::Gemm g{p.U, p.WIT, NTOK, NP, DM}; pg8::StaticOrder S; S.init(NTOK, 12 * 256, (int)gridDim.x - 64, (int)blockIdx.x - 64); S.cols(0, 8, 6);
            pg8::EpiBf16T<true> E{p.P, NP};
            pg8::gemm_phase(lds, g, S, E);
        }
        grid_barrier(p.BAR + 16, gridDim.x - 64u);
    }
    att_fast(p, lds, 0, (int)gridDim.x);
    STAMP(5);
    grid_barrier(p.BAR, gridDim.x * 2u);
    ml_post(p);
    asm volatile("s_waitcnt vmcnt(0)" ::: "memory");
    __syncthreads();
    STAMP(6);
    {
        pg8::Gemm g{p.MIX, p.WOT, NTOK, DM, DM}; pg8::PanelOrder S{(int)blockIdx.x};
        pg8::EpiBf16T<false> E{p.U, DM};
        pg8::gemm_phase(lds, g, S, E);
    }
    STAMP(7);
    asm volatile("s_waitcnt vmcnt(0)" ::: "memory");
    __syncthreads();
    STAMP(8);
    phase_final(p);
    STAMP(9);
#if PROBE_SEL
    grid_barrier(p.BAR, gridDim.x * 3u);
    if (blockIdx.x == 0 && threadIdx.x == 0) {
        const unsigned long long* a = p.TS; const unsigned long long* c = p.TS + 32;
        unsigned long long d = 0;
        if (PROBE_SEL == 1) d = c[1] - c[0];
        if (PROBE_SEL == 2) d = c[3] - c[2];
        if (PROBE_SEL == 3) d = c[5] - c[4];
        if (PROBE_SEL == 4) d = a[5] - a[4];
        if (PROBE_SEL == 5) d = c[7] - c[6];
        if (PROBE_SEL == 6) d = c[9] - c[8];
        if (PROBE_SEL == 7) d = (c[2] - c[1]) + (c[4] - c[3]) + (c[6] - c[5]) + (c[8] - c[7]);
        d *= 4;
        const unsigned long long t0 = __builtin_amdgcn_s_memrealtime();
        while (__builtin_amdgcn_s_memrealtime() - t0 < d) __builtin_amdgcn_s_sleep(8);
    }
#endif
}

extern "C" void kernel_launch(void* const* d_in, const int* in_sizes, int n_in, void* d_out, int out_size, void* d_ws, size_t ws_size, hipStream_t stream) {
    static int grid_blocks = 0;
    if (!grid_blocks) {
        int dev = 0, cus = 0, per_cu = 0;
        (void)hipGetDevice(&dev);
        (void)hipDeviceGetAttribute(&cus, hipDeviceAttributeMultiprocessorCount, dev);
        (void)hipFuncSetAttribute((const void*)hymba_fwd, hipFuncAttributeMaxDynamicSharedMemorySize, LDS_BYTES);
        (void)hipOccupancyMaxActiveBlocksPerMultiprocessor(&per_cu, (const void*)hymba_fwd, 512, LDS_BYTES);
        (void)hipGetLastError();
        if (per_cu < 1) per_cu = 1;
        grid_blocks = cus;
        if (grid_blocks > 256) grid_blocks = 256;
    }
    Params p{};
    p.x = (const float*)d_in[0]; p.norm_g = (const float*)d_in[1]; p.w_in = (const float*)d_in[2]; p.b_ig = (const float*)d_in[3]; p.b_fg = (const float*)d_in[4];
    p.conv_w = (const float*)d_in[5]; p.conv_b = (const float*)d_in[6]; p.hn_g = (const float*)d_in[7]; p.w_out = (const float*)d_in[8]; p.fin_g = (const float*)d_in[9];
    p.out = (float*)d_out;
    unsigned char* ws = (unsigned char*)d_ws; size_t off = 0;
    p.U = (bf16_t*)(ws + off); p.HRAW = (float*)(ws + off); off += (size_t)NTOK * DM * 2;
    p.P = (bf16_t*)(ws + off); off += (size_t)NTOK * NP * 2;
    p.MIX = (bf16_t*)(ws + off); off += (size_t)NTOK * DM * 2;
    p.WIT = (bf16_t*)(ws + off); off += (size_t)NP * DM * 2;
    p.WOT = (bf16_t*)(ws + off); off += (size_t)DM * DM * 2;
    p.G = (float*)(ws + off); off += (size_t)NTOK * 8 * 4;
    p.MLG = (float*)(ws + off); off += (size_t)64 * 4 * SEQ * 4;
    p.ROWSS = (float*)(ws + off); off += (size_t)NTOK * 4;
    p.TS = (unsigned long long*)(ws + off); off += 4096;
    p.BAR = (unsigned*)(ws + off); off += 256;
    p.HRAW16 = (bf16_t*)(ws + off); off += (size_t)NTOK * 512 * 2;
    p.never = 0;
    if (off > ws_size) { fprintf(stderr, "workspace too small: need %zu have %zu\n", off, ws_size); return; }
    (void)hipMemsetAsync(p.BAR, 0, 256, stream);
    void* args[] = {&p};
    hipError_t e = hipLaunchCooperativeKernel((const void*)hymba_fwd, dim3(grid_blocks), dim3(512), args, LDS_BYTES, stream);
    if (e != hipSuccess) fprintf(stderr, "cooperative launch failed: %s (grid %d)\n", hipGetErrorString(e), grid_blocks);
}
```

```cpp
#include <hip/hip_runtime.h>
#include <hip/hip_cooperative_groups.h>
#include <cstdio>
namespace cg = cooperative_groups;

#ifndef FAST_ATT
#define FAST_ATT 1
#endif
#ifndef FAST_ML
#define FAST_ML 1
#endif

#define LAS __attribute__((address_space(3)))
typedef unsigned short bf16_t;
typedef short bf16x8 __attribute__((ext_vector_type(8)));
typedef short s16x4 __attribute__((ext_vector_type(4)));
typedef float f32x4 __attribute__((ext_vector_type(4)));
typedef unsigned u32x4 __attribute__((ext_vector_type(4)));
typedef unsigned u32x2 __attribute__((ext_vector_type(2)));

constexpr int NTOK = 65536, DM = 1024, SEQ = 4096, NP = 4608, NIN = 4616;
constexpr int LDS_BYTES = 131072 + 8192;
constexpr float EPS = 1e-6f;
constexpr float LOG2E = 1.4426950408889634f, LN2 = 0.6931471805599453f;

struct Params {
    const float *x, *norm_g, *w_in, *b_ig, *b_fg, *conv_w, *conv_b, *hn_g, *w_out, *fin_g;
    float* out;
    bf16_t *U, *P, *MIX, *WIT, *WOT;
    float *G, *MLG, *ROWSS, *HRAW;
    unsigned long long* TS;
    bf16_t* HRAW16;
    unsigned* BAR; int never;
    int pad_;
};

__device__ __forceinline__ float bf2f(bf16_t b) { return __uint_as_float(((unsigned)b) << 16); }
__device__ __forceinline__ float bflo(unsigned w) { return __uint_as_float(w << 16); }
__device__ __forceinline__ float bfhi(unsigned w) { return __uint_as_float(w & 0xffff0000u); }
__device__ __forceinline__ unsigned cvt_pk_bf16(float lo, float hi) { unsigned r; asm volatile("v_cvt_pk_bf16_f32 %0, %1, %2" : "=v"(r) : "v"(lo), "v"(hi)); return r; }
__device__ __forceinline__ bf16_t f2bf(float f) { return (bf16_t)(cvt_pk_bf16(f, 0.f) & 0xffffu); }
template <int CTRL> __device__ __forceinline__ float dpp_mov(float v) { return __builtin_bit_cast(float, __builtin_amdgcn_update_dpp(0, __builtin_bit_cast(int, v), CTRL, 0xF, 0xF, true)); }
__device__ __forceinline__ float sum8(float v) { v += dpp_mov<0xB1>(v); v += dpp_mov<0x4E>(v); v += dpp_mov<0x141>(v); return v; }
__device__ __forceinline__ float sum16(float v) { v = sum8(v); v += dpp_mov<0x140>(v); return v; }
__device__ __forceinline__ float lane_of(float v, int l) { return __builtin_bit_cast(float, __builtin_amdgcn_readlane(__builtin_bit_cast(int, v), l)); }
__device__ __forceinline__ float wave_sum(float v) { v = sum16(v); return (lane_of(v, 0) + lane_of(v, 16)) + (lane_of(v, 32) + lane_of(v, 48)); }
__device__ __forceinline__ float sigmoidf_(float z) { return __builtin_amdgcn_rcpf(1.f + __builtin_amdgcn_exp2f(-z * LOG2E)); }


__device__ __forceinline__ void grid_barrier(unsigned* ctr, unsigned target) {
    asm volatile("s_waitcnt vmcnt(0)" ::: "memory");
    __syncthreads();
    if (threadIdx.x == 0) {
        __builtin_amdgcn_fence(__ATOMIC_RELEASE, "agent");
        asm volatile("s_waitcnt vmcnt(0)" ::: "memory");
        __hip_atomic_fetch_add(ctr, 1u, __ATOMIC_RELAXED, __HIP_MEMORY_SCOPE_AGENT);
        while (__hip_atomic_load(ctr, __ATOMIC_RELAXED, __HIP_MEMORY_SCOPE_AGENT) < target) __builtin_amdgcn_s_sleep(2);
        __builtin_amdgcn_fence(__ATOMIC_ACQUIRE, "agent");
        asm volatile("s_waitcnt vmcnt(0)" ::: "memory");
    }
    __syncthreads();
}

__device__ __forceinline__ void grid_arrive(unsigned* ctr) {
    asm volatile("s_waitcnt vmcnt(0)" ::: "memory");
    __syncthreads();
    if (threadIdx.x == 0) {
        __builtin_amdgcn_fence(__ATOMIC_RELEASE, "agent");
        asm volatile("s_waitcnt vmcnt(0)" ::: "memory");
        __hip_atomic_fetch_add(ctr, 1u, __ATOMIC_RELAXED, __HIP_MEMORY_SCOPE_AGENT);
    }
}

__device__ __forceinline__ void grid_wait(unsigned* ctr, unsigned target) {
    if (threadIdx.x == 0) {
        while (__hip_atomic_load(ctr, __ATOMIC_RELAXED, __HIP_MEMORY_SCOPE_AGENT) < target) __builtin_amdgcn_s_sleep(4);
        __builtin_amdgcn_fence(__ATOMIC_ACQUIRE, "agent");
        asm volatile("s_waitcnt vmcnt(0)" ::: "memory");
    }
    __syncthreads();
}

namespace pg8 {
constexpr int BM = 256, BK = 64, HALF = 128, HTB = HALF * BK * 2, NXCD = 8, WGM = 4;
__device__ __forceinline__ int lds_byte(int r, int c) { const int st = (r >> 4) * 2 + (c >> 5), rr = r & 15, cc = c & 31, ob = rr * 64 + cc * 2; return st * 1024 + (ob ^ (((ob >> 9) & 1) << 5)); }
__device__ __forceinline__ void stage_rc(int b, int& R, int& C) { const int st = b / 1024, sb = b % 1024, swz = sb ^ (((sb >> 9) & 1) << 5); R = (st >> 1) * 16 + swz / 64; C = (st & 1) * 32 + (swz % 64) / 2; }
__device__ __forceinline__ int perm32(int rho) { const int n = rho >> 4, i = rho & 15; return 8 * (i >> 2) + 4 * n + (i & 3); }
struct Unit { int pm, pn; };
struct Gemm { const bf16_t* A; const bf16_t* Bt; int M, N, K; };
struct StaticOrder {
    int nM, nN, nwg, G, c;
    int a0, a1, shift;
    __device__ void init(int M, int N, int G_, int c_) { nM = M / BM; nN = N / BM; nwg = nM * nN; G = G_; c = c_; a0 = 0; a1 = 1 << 30; shift = 0; }
    __device__ void cols(int a0_, int a1_, int shift_) { a0 = a0_; a1 = a1_; shift = shift_; }
    __device__ bool next(int i, Unit& u) const {
        const long L = (long)i * G + c; if (L >= nwg) return false;
        int wgid = (int)L; { const int q = nwg / NXCD, r = nwg % NXCD, xcd = wgid % NXCD, off = wgid / NXCD; wgid = (xcd < r ? xcd * (q + 1) : r * (q + 1) + (xcd - r) * q) + off; }
        const int nig = WGM * nN, gid = wgid / nig, fm = gid * WGM, gsz = (nM - fm) < WGM ? (nM - fm) : WGM;
        u.pm = fm + ((wgid % nig) % gsz); const int vn = (wgid % nig) / gsz; u.pn = vn < a1 ? vn + a0 : vn + shift; return true;
    }
};
template <bool NT> struct EpiBf16T {
    static constexpr bool PERM = true;
    bf16_t* O; int ldc;
    __device__ __forceinline__ void operator()(const f32x4 (&acc)[2][2][4][2], const Unit& u, int wr, int wc, int fr, int fq) const {
        const int row0 = u.pm * BM + wr * 64 + fr; const int col0 = u.pn * BM + wc * 32 + 8 * fq;
#pragma unroll
        for (int ai = 0; ai < 2; ++ai)
#pragma unroll
            for (int m = 0; m < 4; ++m) { bf16_t* rowp = O + (size_t)(row0 + ai * HALF + m * 16) * ldc + col0;
#pragma unroll
                for (int bj = 0; bj < 2; ++bj) { const f32x4 v0 = acc[ai][bj][m][0], v1 = acc[ai][bj][m][1];
                    u32x4 w; w.x = cvt_pk_bf16(v0[0], v0[1]); w.y = cvt_pk_bf16(v0[2], v0[3]); w.z = cvt_pk_bf16(v1[0], v1[1]); w.w = cvt_pk_bf16(v1[2], v1[3]);
                    if (NT) __builtin_nontemporal_store(w, (u32x4*)(rowp + bj * HALF)); else *(u32x4*)(rowp + bj * HALF) = w; } }
    }
};
struct EpiOut {
    static constexpr bool PERM = false;
    float* C; const float* X; float* rowss;
    __device__ __forceinline__ void operator()(const f32x4 (&acc)[2][2][4][2], const Unit& u, int wr, int wc, int fr, int fq) const {
        const int row0 = u.pm * BM + wr * 64 + fr, col0 = u.pn * BM + wc * 32 + 4 * fq;
#pragma unroll
        for (int ai = 0; ai < 2; ++ai)
#pragma unroll
            for (int m = 0; m < 4; ++m) { const int row = row0 + ai * HALF + m * 16; float* rowp = C + (size_t)row * DM + col0; const float* xp = X + (size_t)row * DM + col0; float ss = 0.f;
#pragma unroll
                for (int bj = 0; bj < 2; ++bj)
#pragma unroll
                    for (int n = 0; n < 2; ++n) { const f32x4 xv = *(const f32x4*)(xp + bj * HALF + n * 16); const f32x4 hv = xv + acc[ai][bj][m][n];
                        *(f32x4*)(rowp + bj * HALF + n * 16) = hv; ss += (hv[0] * hv[0] + hv[1] * hv[1]) + (hv[2] * hv[2] + hv[3] * hv[3]); }
                ss += __shfl_xor(ss, 16); ss += __shfl_xor(ss, 32);
                if (fq == 0) atomicAdd(rowss + row, ss); }
    }
};

struct PanelOrder {
    int c;
    __device__ bool next(int i, Unit& u) const { if (i >= 4) return false; u.pm = c; u.pn = i; return true; }
};
struct EpiOutFused {
    static constexpr bool PERM = false;
    float* C; const float* X; const float* gfin; LAS float* red;
    __device__ __forceinline__ void operator()(const f32x4 (&acc)[2][2][4][2], const Unit& u, int wr, int wc, int fr, int fq) {
        const int row0 = u.pm * BM + wr * 64 + fr, col0 = u.pn * BM + wc * 32 + 4 * fq;
#pragma unroll
        for (int ai = 0; ai < 2; ++ai)
#pragma unroll
            for (int m = 0; m < 4; ++m) { const int row = row0 + ai * HALF + m * 16; float* rowp = C + (size_t)row * DM + col0; const float* xp = X + (size_t)row * DM + col0; float ss = 0.f;
#pragma unroll
                for (int bj = 0; bj < 2; ++bj)
#pragma unroll
                    for (int n = 0; n < 2; ++n) { const f32x4 xv = *(const f32x4*)(xp + bj * HALF + n * 16); const f32x4 hv = xv + acc[ai][bj][m][n];
                        *(f32x4*)(rowp + bj * HALF + n * 16) = hv; ss += (hv[0] * hv[0] + hv[1] * hv[1]) + (hv[2] * hv[2] + hv[3] * hv[3]); }
                ss += __shfl_xor(ss, 16); ss += __shfl_xor(ss, 32);
                if (fq == 0) atomicAdd((float*)(red + ai * HALF + wr * 64 + m * 16 + fr), ss); }
    }
    __device__ __forceinline__ void finish(int pm) {
        const int tid = threadIdx.x;
        LAS float* rstd = red + 256;
        __syncthreads();
        if (tid < 256) rstd[tid] = rsqrtf(red[tid] * (1.f / DM) + EPS);
        __syncthreads();
        float* base = C + (size_t)pm * BM * DM;
#pragma unroll 4
        for (int i = 0; i < 128; ++i) { const int idx4 = i * 512 + tid, row = idx4 >> 8, c4 = (idx4 & 255) * 4;
            f32x4 v = *(f32x4*)(base + (size_t)row * DM + c4); const f32x4 g = *(const f32x4*)(gfin + c4);
            v = v * rstd[row] * g; *(f32x4*)(base + (size_t)row * DM + c4) = v; }
    }
};

template <class Epi, class Sched>
__device__ __forceinline__ void gemm_phase(LAS unsigned char* lds, const Gemm g, const Sched& S, Epi& E) {
    const int tid = threadIdx.x, wid = __builtin_amdgcn_readfirstlane(tid >> 6), lane = tid & 63, wr = wid >> 2, wc = wid & 3, fr = lane & 15, fq = lane >> 4;
    const int K = g.K, nt = K / BK;
    unsigned voffA[2], voffB[2];
#pragma unroll
    for (int i = 0; i < 2; ++i) { int R, C; stage_rc(tid * 16 + i * 8192, R, C); const int Rb = Epi::PERM ? ((R & ~31) + perm32(R & 31)) : R;
        voffA[i] = (unsigned)(R * K + C) * 2u; voffB[i] = (unsigned)(Rb * K + C) * 2u; }
    const size_t kstep = (size_t)(BK * 2);
    const size_t hstep = (size_t)HALF * K * 2;
    const size_t tstep = 2 * hstep;
    const unsigned ldsw = (unsigned)wid * 1024u;
    const int aoff = lds_byte(wr * 64 + fr, fq * 8), boff = lds_byte(wc * 32 + fr, fq * 8);
#define PG8_SA(b, h) (((b) * 2 + (h)) * HTB)
#define PG8_SB(b, h) ((4 + (b) * 2 + (h)) * HTB)
#define PG8_STAGE(bufoff, gbase, voff) do { _Pragma("unroll") for (int _i = 0; _i < 2; ++_i) \
        __builtin_amdgcn_global_load_lds((const unsigned*)((const char*)(gbase) + (voff)[_i]), (LAS unsigned*)(lds + (bufoff) + ldsw + _i * 8192), 16, 0, 0); } while (0)
#define PG8_LDA(dst, b, h) do { _Pragma("unroll") for (int m = 0; m < 4; ++m) _Pragma("unroll") for (int k = 0; k < 2; ++k) dst[m][k] = *(const LAS bf16x8*)(lds + PG8_SA(b, h) + aoff + m * 2048 + k * 1024); } while (0)
#define PG8_LDB(dst, b, h) do { _Pragma("unroll") for (int n = 0; n < 2; ++n) _Pragma("unroll") for (int k = 0; k < 2; ++k) dst[n][k] = *(const LAS bf16x8*)(lds + PG8_SB(b, h) + boff + n * 2048 + k * 1024); } while (0)
#define PG8_MMA(ai, bj, At, Bt) do { __builtin_amdgcn_s_setprio(1); _Pragma("unroll") for (int m = 0; m < 4; ++m) _Pragma("unroll") for (int n = 0; n < 2; ++n) _Pragma("unroll") for (int k = 0; k < 2; ++k) \
        acc[ai][bj][m][n] = __builtin_amdgcn_mfma_f32_16x16x32_bf16(Bt[n][k], At[m][k], acc[ai][bj][m][n], 0, 0, 0); __builtin_amdgcn_s_setprio(0); } while (0)
#define PG8_WAIT_V(n) asm volatile("s_waitcnt vmcnt(" #n ")" ::: "memory")
#define PG8_WAIT_L(n) asm volatile("s_waitcnt lgkmcnt(" #n ")" ::: "memory")
#define PG8_BAR __builtin_amdgcn_s_barrier()
#define PG8_SCHED __builtin_amdgcn_sched_barrier(0)
    Unit cur, nxt; int ui = 0;
    if (!S.next(0, cur)) return;
    f32x4 acc[2][2][4][2];
#pragma unroll
    for (int a = 0; a < 2; ++a)
#pragma unroll
        for (int b = 0; b < 2; ++b)
#pragma unroll
            for (int m = 0; m < 4; ++m)
#pragma unroll
                for (int n = 0; n < 2; ++n) acc[a][b][m][n] = (f32x4){0.f, 0.f, 0.f, 0.f};
    bf16x8 At[4][2], B0[2][2], B1[2][2];
    const char* cA = (const char*)g.A + (size_t)cur.pm * tstep; const char* cB = (const char*)g.Bt + (size_t)cur.pn * tstep;
    PG8_STAGE(PG8_SB(0, 0), cB, voffB); PG8_STAGE(PG8_SA(0, 0), cA, voffA); PG8_STAGE(PG8_SB(0, 1), cB + hstep, voffB); PG8_STAGE(PG8_SA(0, 1), cA + hstep, voffA);
    if (wr == 1) PG8_BAR;
    PG8_WAIT_V(4); PG8_BAR;
    PG8_STAGE(PG8_SB(1, 0), cB + kstep, voffB); PG8_STAGE(PG8_SA(1, 0), cA + kstep, voffA); PG8_STAGE(PG8_SB(1, 1), cB + hstep + kstep, voffB);
    PG8_WAIT_V(6); PG8_BAR;
    for (;;) {
        const bool has_next = S.next(ui + 1, nxt);
        const char* nA = has_next ? (const char*)g.A + (size_t)nxt.pm * tstep : cA; const char* nB = has_next ? (const char*)g.Bt + (size_t)nxt.pn * tstep : cB;
        for (int t = 0; t < nt; t += 2) {
            const bool last = (t == nt - 2);
            const char* a1 = cA + (size_t)(t + 1) * kstep;
            const char* a2 = last ? nA : cA + (size_t)(t + 2) * kstep; const char* b2 = last ? nB : cB + (size_t)(t + 2) * kstep;
            const char* a3 = a2 + kstep; const char* b3 = b2 + kstep;
            PG8_LDB(B0, 0, 0); PG8_SCHED; PG8_LDA(At, 0, 0); PG8_STAGE(PG8_SA(1, 1), a1 + hstep, voffA);
            PG8_WAIT_L(8); PG8_BAR; PG8_WAIT_L(0); PG8_MMA(0, 0, At, B0); PG8_BAR; PG8_SCHED;
            PG8_LDB(B1, 0, 1); PG8_STAGE(PG8_SB(0, 0), b2, voffB);
            PG8_BAR; PG8_WAIT_L(0); PG8_MMA(0, 1, At, B1); PG8_BAR;
            PG8_LDA(At, 0, 1); PG8_STAGE(PG8_SA(0, 0), a2, voffA);
            PG8_BAR; PG8_WAIT_L(0); PG8_MMA(1, 0, At, B0); PG8_BAR; PG8_SCHED;
            PG8_STAGE(PG8_SB(0, 1), b2 + hstep, voffB);
            PG8_WAIT_V(6); PG8_BAR; PG8_MMA(1, 1, At, B1); PG8_BAR;
            PG8_LDB(B0, 1, 0); PG8_SCHED; PG8_LDA(At, 1, 0); PG8_STAGE(PG8_SA(0, 1), a2 + hstep, voffA);
            PG8_WAIT_L(8); PG8_BAR; PG8_WAIT_L(0); PG8_MMA(0, 0, At, B0); PG8_BAR; PG8_SCHED;
            PG8_LDB(B1, 1, 1); PG8_STAGE(PG8_SB(1, 0), b3, voffB);
            PG8_BAR; PG8_WAIT_L(0); PG8_MMA(0, 1, At, B1); PG8_BAR;
            PG8_LDA(At, 1, 1); PG8_STAGE(PG8_SA(1, 0), a3, voffA);
            PG8_BAR; PG8_WAIT_L(0); PG8_MMA(1, 0, At, B0); PG8_BAR; PG8_SCHED;
            PG8_STAGE(PG8_SB(1, 1), b3 + hstep, voffB);
            PG8_WAIT_V(6); PG8_BAR; PG8_MMA(1, 1, At, B1); PG8_BAR;
        }
        E(acc, cur, wr, wc, fr, fq);
        if (!has_next) break;
#pragma unroll
        for (int a = 0; a < 2; ++a)
#pragma unroll
            for (int b = 0; b < 2; ++b)
#pragma unroll
                for (int m = 0; m < 4; ++m)
#pragma unroll
                    for (int n = 0; n < 2; ++n) acc[a][b][m][n] = (f32x4){0.f, 0.f, 0.f, 0.f};
        cur = nxt; cA = nA; cB = nB; ++ui;
    }
    PG8_WAIT_V(0);
    if (wr == 0) PG8_BAR;
    PG8_BAR;
#undef PG8_SA
#undef PG8_SB
#undef PG8_STAGE
#undef PG8_LDA
#undef PG8_LDB
#undef PG8_MMA
#undef PG8_WAIT_V
#undef PG8_WAIT_L
#undef PG8_BAR
#undef PG8_SCHED
}
}

__device__ __forceinline__ void phase_prep(const Params& p, LAS unsigned char* lds) {
    const int tid = threadIdx.x, lane = tid & 63, wid = tid >> 6;
    const int gt = blockIdx.x * 512 + tid, NGT = gridDim.x * 512;
    {
        LAS float* scr = (LAS float*)(lds + wid * 8448);
        const int gwv = blockIdx.x * 8 + wid, NGWV = gridDim.x * 8;
        constexpr int I_IN = (DM / 64) * (NP / 32), I_OUT = (DM / 64) * (DM / 32);
        for (int it = gwv; it < I_IN + I_OUT; it += NGWV) {
            const bool isin = it < I_IN; const int r = isin ? it : it - I_IN;
            const float* W = isin ? p.w_in : p.w_out; const int ldw = isin ? NIN : DM, nblk = isin ? NP / 32 : DM / 32;
            bf16_t* WT = isin ? p.WIT : p.WOT;
            const int kb = r / nblk, nb = r % nblk, k0 = 64 * kb, n0 = 32 * nb;
            const float sc = (isin && n0 < 512) ? 0.125f * LOG2E : 1.0f;
#pragma unroll 8
            for (int i = 0; i < 32; ++i) { const int kk = 2 * i + (lane >> 5); scr[kk * 33 + (lane & 31)] = W[(size_t)(k0 + kk) * ldw + n0 + (lane & 31)] * sc; }
            asm volatile("s_waitcnt lgkmcnt(0)" ::: "memory");
            const int cch = lane & 7;
#pragma unroll
            for (int j = 0; j < 4; ++j) { const int n = (lane >> 3) + 8 * j; const LAS float* s = scr + (8 * cch) * 33 + n;
                u32x4 o; o.x = cvt_pk_bf16(s[0 * 33], s[1 * 33]); o.y = cvt_pk_bf16(s[2 * 33], s[3 * 33]); o.z = cvt_pk_bf16(s[4 * 33], s[5 * 33]); o.w = cvt_pk_bf16(s[6 * 33], s[7 * 33]);
                *(u32x4*)(WT + (size_t)(n0 + n) * DM + k0 + 8 * cch) = o; }
            asm volatile("s_waitcnt lgkmcnt(0)" ::: "memory");
        }
        __syncthreads();
    }
    LAS float* wl = (LAS float*)lds;
    for (int r = tid; r < DM; r += 512) { const f32x4 a = *(const f32x4*)(p.w_in + (size_t)r * NIN + NP), bq = *(const f32x4*)(p.w_in + (size_t)r * NIN + NP + 4);
        *(LAS f32x4*)(wl + r * 8) = a; *(LAS f32x4*)(wl + r * 8 + 4) = bq; }
    __syncthreads();
    float gk[16], wg[16][8];
#pragma unroll
    for (int j = 0; j < 4; ++j)
#pragma unroll
        for (int e = 0; e < 4; ++e) { const int k = 4 * lane + 256 * j + e; const float g = p.norm_g[k]; gk[j * 4 + e] = g;
            const f32x4 a = *(const LAS f32x4*)(wl + k * 8), bq = *(const LAS f32x4*)(wl + k * 8 + 4);
#pragma unroll
            for (int c = 0; c < 4; ++c) { wg[j * 4 + e][c] = g * a[c]; wg[j * 4 + e][4 + c] = g * bq[c]; } }
    const int gci = 4 * (lane >> 5) + 2 * ((lane >> 4) & 1) + ((lane >> 3) & 1);
    const float gbias = (gci < 4) ? p.b_ig[gci] : p.b_fg[gci - 4];
    const int gw = blockIdx.x * 8 + wid, NGW = gridDim.x * 8;
    f32x4 v[4], vn[4], vnn[4];
#pragma unroll
    for (int j = 0; j < 4; ++j) { v[j] = __builtin_nontemporal_load((const f32x4*)(p.x + (size_t)gw * DM + 4 * lane + 256 * j)); vn[j] = __builtin_nontemporal_load((const f32x4*)(p.x + (size_t)(gw + NGW) * DM + 4 * lane + 256 * j)); }
    for (int row = gw; row < NTOK; row += NGW) {
        const int nrow = row + 2 * NGW;
        if (nrow < NTOK) {
#pragma unroll
            for (int j = 0; j < 4; ++j) vnn[j] = __builtin_nontemporal_load((const f32x4*)(p.x + (size_t)nrow * DM + 4 * lane + 256 * j));
        }
        float ss = 0.f;
#pragma unroll
        for (int j = 0; j < 4; ++j) ss += (v[j][0] * v[j][0] + v[j][1] * v[j][1]) + (v[j][2] * v[j][2] + v[j][3] * v[j][3]);
        ss = wave_sum(ss);
        const float rstd = rsqrtf(ss * (1.f / DM) + EPS);
        float gacc[8];
#pragma unroll
        for (int c = 0; c < 8; ++c) gacc[c] = 0.f;
#pragma unroll
        for (int j = 0; j < 4; ++j) {
#pragma unroll
            for (int e = 0; e < 4; ++e) {
#pragma unroll
                for (int c = 0; c < 8; ++c) gacc[c] += v[j][e] * wg[j * 4 + e][c];
            }
            u32x2 w; w.x = cvt_pk_bf16(v[j][0] * rstd * gk[j * 4 + 0], v[j][1] * rstd * gk[j * 4 + 1]); w.y = cvt_pk_bf16(v[j][2] * rstd * gk[j * 4 + 2], v[j][3] * rstd * gk[j * 4 + 3]);
            *(u32x2*)(p.U + (size_t)row * DM + 4 * lane + 256 * j) = w;
        }
        float f4[4], f2[2], f1;
        { const bool up = (lane & 32) != 0;
#pragma unroll
          for (int c = 0; c < 4; ++c) { const float keep = up ? gacc[c + 4] : gacc[c], send = up ? gacc[c] : gacc[c + 4]; f4[c] = keep + __shfl_xor(send, 32); } }
        { const bool up = (lane & 16) != 0;
#pragma unroll
          for (int c = 0; c < 2; ++c) { const float keep = up ? f4[c + 2] : f4[c], send = up ? f4[c] : f4[c + 2]; f2[c] = keep + __shfl_xor(send, 16); } }
        { const bool up = (lane & 8) != 0; const float keep = up ? f2[1] : f2[0], send = up ? f2[0] : f2[1]; f1 = keep + __shfl_xor(send, 8); }
        f1 = sum8(f1);
        if ((lane & 7) == 0) { const int c = 4 * (lane >> 5) + 2 * ((lane >> 4) & 1) + ((lane >> 3) & 1);
            p.G[(size_t)row * 8 + c] = f1 * rstd + gbias; }
#pragma unroll
        for (int j = 0; j < 4; ++j) { v[j] = vn[j]; vn[j] = vnn[j]; }
    }
}

__device__ __forceinline__ float softplus_acc(float z) { return fmaxf(z, 0.f) + log1pf(expf(-fabsf(z))); }

__device__ void att_naive(const Params& p, int nb_first, int nb_count) {
    const int tix = ((int)blockIdx.x - nb_first) * 512 + (int)threadIdx.x, nthr = nb_count * 512;
    for (int idx = tix; idx < 16 * 8 * SEQ; idx += nthr) {
        const int t = idx & (SEQ - 1), h = (idx >> 12) & 7, b = idx >> 15;
        const size_t row = (size_t)b * SEQ + t;
        const bf16_t* qp = p.P + row * NP + h * 64;
        float q[64], acc[64];
#pragma unroll
        for (int c = 0; c < 8; ++c) { const u32x4 w = *(const u32x4*)(qp + 8 * c);
#pragma unroll
            for (int e = 0; e < 4; ++e) { q[8 * c + 2 * e] = bflo(w[e]); q[8 * c + 2 * e + 1] = bfhi(w[e]); } }
#pragma unroll
        for (int d = 0; d < 64; ++d) acc[d] = 0.f;
        float carry = 0.f;
        for (int s = t - 1; s >= 0; --s) {
            const bf16_t* kp = p.P + ((size_t)b * SEQ + s) * NP + 512 + h * 64;
            const bf16_t* vp = kp + 512;
            float z = 0.f;
#pragma unroll
            for (int c = 0; c < 8; ++c) { const u32x4 w = *(const u32x4*)(kp + 8 * c);
#pragma unroll
                for (int e = 0; e < 4; ++e) { z += q[8 * c + 2 * e] * bflo(w[e]); z += q[8 * c + 2 * e + 1] * bfhi(w[e]); } }
            const float sp = softplus_acc(z);
            const float wgt = expf(z - sp + carry);
#pragma unroll
            for (int c = 0; c < 8; ++c) { const u32x4 w = *(const u32x4*)(vp + 8 * c);
#pragma unroll
                for (int e = 0; e < 4; ++e) { acc[8 * c + 2 * e] += wgt * bflo(w[e]); acc[8 * c + 2 * e + 1] += wgt * bfhi(w[e]); } }
            carry -= sp;
            if (carry < -104.f) break;
        }
        const bf16_t* zp = p.P + row * NP + 1536 + h * 64;
        bf16_t* op = p.MIX + row * DM + h * 64;
#pragma unroll
        for (int c = 0; c < 8; ++c) { const u32x4 w = *(const u32x4*)(zp + 8 * c); u32x4 o;
#pragma unroll
            for (int e = 0; e < 4; ++e) { const float z0 = bflo(w[e]), z1 = bfhi(w[e]);
                o[e] = cvt_pk_bf16(acc[8 * c + 2 * e] * z0 * sigmoidf_(z0), acc[8 * c + 2 * e + 1] * z1 * sigmoidf_(z1)); }
            *(u32x4*)(op + 8 * c) = o; }
    }
}

constexpr int AT_ROWB = 144, AT_TILE = 64 * AT_ROWB;
__device__ __forceinline__ s16x4 tr_read4(LAS unsigned char* p) { return __builtin_amdgcn_ds_read_tr16_b64_v4i16((LAS s16x4*)p); }

__device__ void att_fast(const Params& p, LAS unsigned char* lds, int nb_first, int nb_count) {
    const int tid = threadIdx.x, wid = __builtin_amdgcn_readfirstlane(tid >> 6), lane = tid & 63, fr = lane & 15, fq = lane >> 4;
    constexpr int AT_T2 = 128 * AT_ROWB;
    LAS int* flags = (LAS int*)(lds + 4 * AT_T2);
    bf16x8 T0, T1, TONE;
#pragma unroll
    for (int jj = 0; jj < 8; ++jj) { const int j = 16 * (jj >> 2) + 4 * fq + (jj & 3); T0[jj] = (j > fr) ? (short)0x3F80 : (short)0; T1[jj] = (j > 16 + fr) ? (short)0x3F80 : (short)0; TONE[jj] = (short)0x3F80; }
    const int srow = tid >> 3, sch = tid & 7;
    constexpr int NU = 16 * 8 * 32;
    bf16x8 Qn[2]; u32x4 kn[2], vn[2];
#define ATT_DECODE(uu, qb_, h_, b_) const int qb_ = (((uu) >> 3) ^ ((uu) >> 8)) & 31, h_ = (uu) & 7, b_ = (uu) >> 8
#define ATT_FETCH(uu) do { ATT_DECODE(uu, qb2, h2, b2); const size_t rq2 = (size_t)b2 * SEQ + qb2 * 128 + 16 * wid + fr; \
        _Pragma("unroll") for (int t = 0; t < 2; ++t) Qn[t] = *(const bf16x8*)(p.P + rq2 * NP + h2 * 64 + 32 * t + 8 * fq); \
        const bf16_t* kv2 = p.P + ((size_t)b2 * SEQ + srow + 128 * qb2) * NP + 512 + h2 * 64 + sch * 8; \
        _Pragma("unroll") for (int s2 = 0; s2 < 2; ++s2) { kn[s2] = *(const u32x4*)(kv2 + (size_t)(64 * s2) * NP); vn[s2] = *(const u32x4*)(kv2 + (size_t)(64 * s2) * NP + 512); } } while (0)
    int u = (int)blockIdx.x - nb_first;
    if (u < NU) ATT_FETCH(u);
    for (; u < NU; u += nb_count) {
        ATT_DECODE(u, qb, h, b);
        const int qw0 = qb * 128 + 16 * wid, tq = qw0 + fr;
        const size_t rowq = (size_t)b * SEQ + tq;
        bf16x8 Qf[2];
#pragma unroll
        for (int t = 0; t < 2; ++t) Qf[t] = Qn[t];
        f32x4 oacc[4];
#pragma unroll
        for (int d = 0; d < 4; ++d) oacc[d] = (f32x4){0.f, 0.f, 0.f, 0.f};
        float carry = 0.f;
        const int ktop = qb;
        const bf16_t* kvbase = p.P + ((size_t)b * SEQ + srow) * NP + 512 + h * 64 + sch * 8;
        u32x4 kreg[2], vreg[2];
#pragma unroll
        for (int s2 = 0; s2 < 2; ++s2) { *(LAS u32x4*)(lds + (srow + 64 * s2) * AT_ROWB + sch * 16) = kn[s2]; *(LAS u32x4*)(lds + AT_T2 + (srow + 64 * s2) * AT_ROWB + sch * 16) = vn[s2]; }
        u32x2 zw4[4];
#pragma unroll
        for (int d = 0; d < 4; ++d) zw4[d] = *(const u32x2*)(p.P + rowq * NP + 1536 + h * 64 + 16 * d + 4 * fq);
        if (u + nb_count < NU) ATT_FETCH(u + nb_count);
        __syncthreads();
        for (int it = 0;; ++it) {
            const int kt = ktop - it, buf = it & 1;
            if (kt > 0) {
#pragma unroll
                for (int s2 = 0; s2 < 2; ++s2) { kreg[s2] = *(const u32x4*)(kvbase + (size_t)(128 * (kt - 1) + 64 * s2) * NP); vreg[s2] = *(const u32x4*)(kvbase + (size_t)(128 * (kt - 1) + 64 * s2) * NP + 512); }
            }
#pragma unroll 1
          for (int sub = 1; sub >= 0; --sub) {
            const int k0 = 128 * kt + 64 * sub;
            const bool wdone = __all(carry < -150.1f);
            if (!wdone && k0 <= qw0 + 15) {
                LAS unsigned char* Kb = lds + buf * 2 * AT_T2 + sub * 64 * AT_ROWB; LAS unsigned char* Vb = Kb + AT_T2;
                f32x4 z[4];
#pragma unroll
                for (int k4 = 0; k4 < 4; ++k4) { z[k4] = (f32x4){0.f, 0.f, 0.f, 0.f};
#pragma unroll
                    for (int t = 0; t < 2; ++t) { const bf16x8 A = *(const LAS bf16x8*)(Kb + (16 * k4 + fr) * AT_ROWB + (32 * t + 8 * fq) * 2);
                        z[k4] = __builtin_amdgcn_mfma_f32_16x16x32_bf16(A, Qf[t], z[k4], 0, 0, 0); } }
                float lneg[4][4], lpos[4][4];
#pragma unroll
                for (int k4 = 0; k4 < 4; ++k4)
#pragma unroll
                    for (int r = 0; r < 4; ++r) { const float a = z[k4][r]; const bool strict = (k0 + 16 * k4 + 4 * fq + r) < tq;
                        const float e = __builtin_amdgcn_exp2f(-fabsf(a));
                        const float sp = fmaxf(a, 0.f) + __builtin_amdgcn_logf(1.f + e);
                        lneg[k4][r] = strict ? -sp : 0.f; lpos[k4][r] = a - sp; }
                bf16x8 Lf[2];
#pragma unroll
                for (int t = 0; t < 2; ++t) { u32x4 w; w.x = cvt_pk_bf16(lneg[2 * t][0], lneg[2 * t][1]); w.y = cvt_pk_bf16(lneg[2 * t][2], lneg[2 * t][3]);
                    w.z = cvt_pk_bf16(lneg[2 * t + 1][0], lneg[2 * t + 1][1]); w.w = cvt_pk_bf16(lneg[2 * t + 1][2], lneg[2 * t + 1][3]); Lf[t] = __builtin_bit_cast(bf16x8, w); }
                const f32x4 c4 = (f32x4){carry, carry, carry, carry};
                f32x4 E[4];
                E[0] = __builtin_amdgcn_mfma_f32_16x16x32_bf16(T0, Lf[0], c4, 0, 0, 0); E[0] = __builtin_amdgcn_mfma_f32_16x16x32_bf16(TONE, Lf[1], E[0], 0, 0, 0);
                E[1] = __builtin_amdgcn_mfma_f32_16x16x32_bf16(T1, Lf[0], c4, 0, 0, 0); E[1] = __builtin_amdgcn_mfma_f32_16x16x32_bf16(TONE, Lf[1], E[1], 0, 0, 0);
                E[2] = __builtin_amdgcn_mfma_f32_16x16x32_bf16(T0, Lf[1], c4, 0, 0, 0);
                E[3] = __builtin_amdgcn_mfma_f32_16x16x32_bf16(T1, Lf[1], c4, 0, 0, 0);
                float aw[4][4];
#pragma unroll
                for (int k4 = 0; k4 < 4; ++k4)
#pragma unroll
                    for (int r = 0; r < 4; ++r) { const bool strict = (k0 + 16 * k4 + 4 * fq + r) < tq;
                        const float ex = __builtin_amdgcn_exp2f(lpos[k4][r] + E[k4][r]); aw[k4][r] = strict ? ex : 0.f; }
                {
                    f32x4 tot4 = __builtin_amdgcn_mfma_f32_16x16x32_bf16(TONE, Lf[0], c4, 0, 0, 0); tot4 = __builtin_amdgcn_mfma_f32_16x16x32_bf16(TONE, Lf[1], tot4, 0, 0, 0);
                    carry = tot4[0]; }
                bf16x8 Af[2];
#pragma unroll
                for (int t = 0; t < 2; ++t) { u32x4 w; w.x = cvt_pk_bf16(aw[2 * t][0], aw[2 * t][1]); w.y = cvt_pk_bf16(aw[2 * t][2], aw[2 * t][3]);
                    w.z = cvt_pk_bf16(aw[2 * t + 1][0], aw[2 * t + 1][1]); w.w = cvt_pk_bf16(aw[2 * t + 1][2], aw[2 * t + 1][3]); Af[t] = __builtin_bit_cast(bf16x8, w); }
#pragma unroll
                for (int d = 0; d < 4; ++d)
#pragma unroll
                    for (int t = 0; t < 2; ++t) { LAS unsigned char* a0 = Vb + (32 * t + 4 * fq + (fr >> 2)) * AT_ROWB + (16 * d + 4 * (fr & 3)) * 2;
                        const s16x4 lo = tr_read4(a0), hi = tr_read4(a0 + 16 * AT_ROWB);
                        const bf16x8 Vf = __builtin_shufflevector(lo, hi, 0, 1, 2, 3, 4, 5, 6, 7);
                        oacc[d] = __builtin_amdgcn_mfma_f32_16x16x32_bf16(Vf, Af[t], oacc[d], 0, 0, 0); }
            }
          }
            const bool wdone2 = __all(carry < -150.1f);
            if (lane == 0) flags[buf * 8 + wid] = wdone2 ? 1 : 0;
            if (kt > 0) {
#pragma unroll
                for (int s2 = 0; s2 < 2; ++s2) { *(LAS u32x4*)(lds + (buf ^ 1) * 2 * AT_T2 + (srow + 64 * s2) * AT_ROWB + sch * 16) = kreg[s2]; *(LAS u32x4*)(lds + (buf ^ 1) * 2 * AT_T2 + AT_T2 + (srow + 64 * s2) * AT_ROWB + sch * 16) = vreg[s2]; }
            }
            __syncthreads();
            if (kt == 0) break;
            int alld = 1;
#pragma unroll
            for (int w = 0; w < 8; ++w) alld &= flags[buf * 8 + w];
            if (alld) break;
        }
#pragma unroll
        for (int d = 0; d < 4; ++d) { const int col = h * 64 + 16 * d + 4 * fq;
            const u32x2 zw = zw4[d];
            const float z0 = bflo(zw.x), z1 = bfhi(zw.x), z2 = bflo(zw.y), z3 = bfhi(zw.y);
            u32x2 o; o.x = cvt_pk_bf16(oacc[d][0] * z0 * sigmoidf_(z0), oacc[d][1] * z1 * sigmoidf_(z1)); o.y = cvt_pk_bf16(oacc[d][2] * z2 * sigmoidf_(z2), oacc[d][3] * z3 * sigmoidf_(z3));
            *(u32x2*)(p.MIX + rowq * DM + col) = o; }
    }
#undef ATT_DECODE
#undef ATT_FETCH
}

constexpr int ML_QROW = 272, ML_TROW = 144, ML_HROW = 528;
constexpr int ML_Q = 0, ML_K = 17408, ML_KT = 34816, ML_VT = 53248, ML_SB = 71680, ML_H = 80896;
constexpr int ML_GA = 114688, ML_GM = ML_GA + 256, ML_GIW = ML_GM + 256, ML_GEN = ML_GIW + 256, ML_GW = ML_GEN + 256, ML_N = ML_GW + 256, ML_RDEN = ML_N + 512, ML_SCAN = ML_RDEN + 256;

__device__ void ml_fast(const Params& p, LAS unsigned char* lds) {
    const int bh = blockIdx.x; if (bh >= 64) return;
    const int b = bh >> 2, h = bh & 3, tid = threadIdx.x, lane = tid & 63, wid = __builtin_amdgcn_readfirstlane(tid >> 6), fr = lane & 15, fq = lane >> 4;
    float* mlg = p.MLG + (size_t)bh * 4 * SEQ;
    {
        LAS float* scan = (LAS float*)(lds + ML_SCAN);
        float a_[8], pm_[8], bc_[8];
#pragma unroll
        for (int i = 0; i < 8; ++i) {
            const int c = wid + 8 * i; const size_t tok = (size_t)b * SEQ + 64 * c + lane;
            const float ig = p.G[tok * 8 + h], fg = p.G[tok * 8 + 4 + h];
            float bc = -softplus_acc(-fg);
#pragma unroll
            for (int o = 1; o < 64; o <<= 1) { const float t = __shfl_up(bc, o); if (lane >= o) bc += t; }
            const float a = ig - bc; float pm = a;
#pragma unroll
            for (int o = 1; o < 64; o <<= 1) { const float t = __shfl_up(pm, o); if (lane >= o) pm = fmaxf(pm, t); }
            a_[i] = a; pm_[i] = pm; bc_[i] = bc;
            if (lane == 63) { scan[c] = bc; scan[64 + c] = pm; }
        }
        __syncthreads();
        if (tid == 0) { float m = 0.f; for (int c = 0; c < 64; ++c) { scan[128 + c] = m; m = scan[c] + fmaxf(m, scan[64 + c]); } }
        __syncthreads();
#pragma unroll
        for (int i = 0; i < 8; ++i) {
            const int c = wid + 8 * i; const float mc = scan[128 + c]; const float M = fmaxf(mc, pm_[i]);
            const int o = 64 * c + lane;
            mlg[o] = a_[i]; mlg[SEQ + o] = M; mlg[2 * SEQ + o] = expf(mc - M); mlg[3 * SEQ + o] = expf(-(bc_[i] + M));
        }
        if (tid < 128) *(LAS float*)(lds + ML_N + tid * 4) = 0.f;
        __syncthreads();
    }
    const int isK = tid >> 8, rg = (tid >> 4) & 15, cg = tid & 15;
    float cw[4][8], cb[8];
    {
        const int ch = isK * 512 + h * 128 + 8 * cg; const float sc = isK ? 0.08838834764831845f : 1.0f;
#pragma unroll
        for (int e = 0; e < 8; ++e) { cb[e] = p.conv_b[ch + e] * sc;
#pragma unroll
            for (int j = 0; j < 4; ++j) cw[j][e] = p.conv_w[j * 1024 + ch + e] * sc; }
    }
    const int vrg = tid >> 5, vcg = tid & 31;
    const int el = tid >> 3, ep = tid & 7;
    const bf16_t* qkbase = p.P + (size_t)b * SEQ * NP + (isK ? 2560 : 2048) + h * 128 + 8 * cg;
    const bf16_t* vbase = p.P + (size_t)b * SEQ * NP + 3072 + h * 128 + 4 * vcg;
    f32x4 Cst[8];
#pragma unroll
    for (int m = 0; m < 8; ++m) Cst[m] = (f32x4){0.f, 0.f, 0.f, 0.f};
    u32x4 raw[7]; u32x2 vraw[4]; float graw = 0.f;
#pragma unroll
    for (int i = 0; i < 7; ++i) { const int r = 4 * rg - 3 + i; raw[i] = (r >= 0) ? *(const u32x4*)(qkbase + (size_t)r * NP) : (u32x4){0u, 0u, 0u, 0u}; }
#pragma unroll
    for (int i = 0; i < 4; ++i) vraw[i] = *(const u32x2*)(vbase + (size_t)(4 * vrg + i) * NP);
    if (tid < 256) graw = mlg[(tid >> 6) * SEQ + (tid & 63)];

    for (int c = 0; c < 64; ++c) {
        {
            float o[4][8];
#pragma unroll
            for (int i = 0; i < 4; ++i)
#pragma unroll
                for (int e = 0; e < 8; ++e) o[i][e] = cb[e];
#pragma unroll
            for (int rr = 0; rr < 7; ++rr) {
                float in[8];
#pragma unroll
                for (int e = 0; e < 4; ++e) { in[2 * e] = bflo(raw[rr][e]); in[2 * e + 1] = bfhi(raw[rr][e]); }
#pragma unroll
                for (int i = 0; i < 4; ++i) { const int j = rr - i; if (j >= 0 && j < 4) {
#pragma unroll
                    for (int e = 0; e < 8; ++e) o[i][e] += cw[j][e] * in[e]; } }
            }
            unsigned pk[4][4];
#pragma unroll
            for (int i = 0; i < 4; ++i)
#pragma unroll
                for (int e = 0; e < 4; ++e) pk[i][e] = cvt_pk_bf16(o[i][2 * e], o[i][2 * e + 1]);
            LAS unsigned char* nat = lds + (isK ? ML_K : ML_Q);
#pragma unroll
            for (int i = 0; i < 4; ++i) *(LAS u32x4*)(nat + (4 * rg + i) * ML_QROW + cg * 16) = (u32x4){pk[i][0], pk[i][1], pk[i][2], pk[i][3]};
            if (isK) {
#pragma unroll
                for (int e = 0; e < 8; ++e) { const int w = e >> 1; unsigned w0, w1;
                    if (e & 1) { w0 = (pk[0][w] >> 16) | (pk[1][w] & 0xffff0000u); w1 = (pk[2][w] >> 16) | (pk[3][w] & 0xffff0000u); }
                    else { w0 = (pk[0][w] & 0xffffu) | (pk[1][w] << 16); w1 = (pk[2][w] & 0xffffu) | (pk[3][w] << 16); }
                    *(LAS u32x2*)(lds + ML_KT + (8 * cg + e) * ML_TROW + 8 * rg) = (u32x2){w0, w1}; }
            }
#pragma unroll
            for (int e = 0; e < 4; ++e) { unsigned w0, w1;
                if (e & 1) { w0 = (vraw[0][e >> 1] >> 16) | (vraw[1][e >> 1] & 0xffff0000u); w1 = (vraw[2][e >> 1] >> 16) | (vraw[3][e >> 1] & 0xffff0000u); }
                else { w0 = (vraw[0][e >> 1] & 0xffffu) | (vraw[1][e >> 1] << 16); w1 = (vraw[2][e >> 1] & 0xffffu) | (vraw[3][e >> 1] << 16); }
                *(LAS u32x2*)(lds + ML_VT + (4 * vcg + e) * ML_TROW + 8 * vrg) = (u32x2){w0, w1}; }
            if (tid < 256) *(LAS float*)(lds + ML_GA + tid * 4) = graw;
        }
        if (c < 63) {
            const int r0 = 64 * (c + 1);
#pragma unroll
            for (int i = 0; i < 7; ++i) raw[i] = *(const u32x4*)(qkbase + (size_t)(r0 + 4 * rg - 3 + i) * NP);
#pragma unroll
            for (int i = 0; i < 4; ++i) vraw[i] = *(const u32x2*)(vbase + (size_t)(r0 + 4 * vrg + i) * NP);
            if (tid < 256) graw = mlg[(tid >> 6) * SEQ + r0 + (tid & 63)];
        }
        const size_t erow = (size_t)b * SEQ + 64 * c + el;
        u32x4 oraw[2], zraw[2];
#pragma unroll
        for (int i = 0; i < 2; ++i) { oraw[i] = *(const u32x4*)(p.P + erow * NP + 3584 + h * 128 + 16 * ep + 8 * i); zraw[i] = *(const u32x4*)(p.P + erow * NP + 4096 + h * 128 + 16 * ep + 8 * i); }
        __syncthreads();
        if (tid < 64) *(LAS float*)(lds + ML_GW + tid * 4) = __expf(*(LAS float*)(lds + ML_GA + tid * 4) - *(LAS float*)(lds + ML_GM + 63 * 4));
        {
            const int lt = wid >> 1;
#pragma unroll
            for (int si = 0; si < 2; ++si) {
                const int st = 2 * (wid & 1) + si;
                f32x4 acc = (f32x4){0.f, 0.f, 0.f, 0.f};
                float val[4] = {0.f, 0.f, 0.f, 0.f};
                if (st <= lt) {
#pragma unroll
                    for (int t = 0; t < 4; ++t) { const bf16x8 A = *(const LAS bf16x8*)(lds + ML_Q + (16 * lt + fr) * ML_QROW + (32 * t + 8 * fq) * 2);
                        const bf16x8 B = *(const LAS bf16x8*)(lds + ML_K + (16 * st + fr) * ML_QROW + (32 * t + 8 * fq) * 2);
                        acc = __builtin_amdgcn_mfma_f32_16x16x32_bf16(A, B, acc, 0, 0, 0); }
                    const float as = *(LAS float*)(lds + ML_GA + (16 * st + fr) * 4);
                    const f32x4 Ml = *(const LAS f32x4*)(lds + ML_GM + (16 * lt + 4 * fq) * 4);
#pragma unroll
                    for (int r = 0; r < 4; ++r) val[r] = (16 * st + fr <= 16 * lt + 4 * fq + r) ? acc[r] * __expf(as - Ml[r]) : 0.f;
                }
#pragma unroll
                for (int r = 0; r < 4; ++r) *(LAS bf16_t*)(lds + ML_SB + (16 * lt + 4 * fq + r) * ML_TROW + (16 * st + fr) * 2) = f2bf(val[r]);
            }
        }
        __syncthreads();
        {
            const u32x4 sw = *(const LAS u32x4*)(lds + ML_SB + el * ML_TROW + ep * 16);
            float rs = 0.f;
#pragma unroll
            for (int e = 0; e < 4; ++e) rs += bflo(sw[e]) + bfhi(sw[e]);
            float qn = 0.f;
#pragma unroll
            for (int i = 0; i < 2; ++i) { const u32x4 qw = *(const LAS u32x4*)(lds + ML_Q + el * ML_QROW + ep * 32 + i * 16);
                const f32x4 n0 = *(const LAS f32x4*)(lds + ML_N + (16 * ep + 8 * i) * 4), n1 = *(const LAS f32x4*)(lds + ML_N + (16 * ep + 8 * i + 4) * 4);
                qn += bflo(qw[0]) * n0[0] + bfhi(qw[0]) * n0[1] + bflo(qw[1]) * n0[2] + bfhi(qw[1]) * n0[3];
                qn += bflo(qw[2]) * n1[0] + bfhi(qw[2]) * n1[1] + bflo(qw[3]) * n1[2] + bfhi(qw[3]) * n1[3]; }
#pragma unroll
            for (int o = 1; o < 8; o <<= 1) { rs += __shfl_xor(rs, o); qn += __shfl_xor(qn, o); }
            if (ep == 0) { const float den = *(LAS float*)(lds + ML_GIW + el * 4) * qn + rs;
                *(LAS float*)(lds + ML_RDEN + el * 4) = 1.f / fmaxf(fabsf(den), *(LAS float*)(lds + ML_GEN + el * 4)); }
        }
        f32x4 acc[4];
        {
            bf16x8 Cb[4];
#pragma unroll
            for (int t = 0; t < 4; ++t) { u32x4 w; w.x = cvt_pk_bf16(Cst[2 * t][0], Cst[2 * t][1]); w.y = cvt_pk_bf16(Cst[2 * t][2], Cst[2 * t][3]);
                w.z = cvt_pk_bf16(Cst[2 * t + 1][0], Cst[2 * t + 1][1]); w.w = cvt_pk_bf16(Cst[2 * t + 1][2], Cst[2 * t + 1][3]); Cb[t] = __builtin_bit_cast(bf16x8, w); }
#pragma unroll
            for (int mt = 0; mt < 4; ++mt) {
                acc[mt] = (f32x4){0.f, 0.f, 0.f, 0.f};
#pragma unroll
                for (int t = 0; t < 4; ++t) { LAS unsigned char* qa = lds + ML_Q + (16 * mt + fr) * ML_QROW + (32 * t + 4 * fq) * 2;
                    const u32x2 lo = *(const LAS u32x2*)qa, hi = *(const LAS u32x2*)(qa + 32);
                    const bf16x8 A = __builtin_bit_cast(bf16x8, (u32x4){lo.x, lo.y, hi.x, hi.y});
                    acc[mt] = __builtin_amdgcn_mfma_f32_16x16x32_bf16(A, Cb[t], acc[mt], 0, 0, 0); }
                const f32x4 iw = *(const LAS f32x4*)(lds + ML_GIW + (16 * mt + 4 * fq) * 4);
                acc[mt] = acc[mt] * iw;
#pragma unroll
                for (int t = 0; t < 2; ++t) { if (mt < 2 && t == 1) continue;
                    const bf16x8 A = *(const LAS bf16x8*)(lds + ML_SB + (16 * mt + fr) * ML_TROW + (32 * t + 8 * fq) * 2);
                    const bf16x8 B = *(const LAS bf16x8*)(lds + ML_VT + (16 * wid + fr) * ML_TROW + (32 * t + 8 * fq) * 2);
                    acc[mt] = __builtin_amdgcn_mfma_f32_16x16x32_bf16(A, B, acc[mt], 0, 0, 0); }
            }
        }
        __syncthreads();
#pragma unroll
        for (int mt = 0; mt < 4; ++mt) { const f32x4 rd = *(const LAS f32x4*)(lds + ML_RDEN + (16 * mt + 4 * fq) * 4);
#pragma unroll
            for (int r = 0; r < 4; ++r) *(LAS float*)(lds + ML_H + (16 * mt + 4 * fq + r) * ML_HROW + (16 * wid + fr) * 4) = acc[mt][r] * rd[r]; }
        {
            const float decay = *(LAS float*)(lds + ML_GIW + 63 * 4);
            bf16x8 Vw[2];
#pragma unroll
            for (int t = 0; t < 2; ++t) { const u32x4 vr = *(const LAS u32x4*)(lds + ML_VT + (16 * wid + fr) * ML_TROW + (32 * t + 8 * fq) * 2);
                const f32x4 w0 = *(const LAS f32x4*)(lds + ML_GW + (32 * t + 8 * fq) * 4), w1 = *(const LAS f32x4*)(lds + ML_GW + (32 * t + 8 * fq + 4) * 4);
                u32x4 w; w.x = cvt_pk_bf16(bflo(vr[0]) * w0[0], bfhi(vr[0]) * w0[1]); w.y = cvt_pk_bf16(bflo(vr[1]) * w0[2], bfhi(vr[1]) * w0[3]);
                w.z = cvt_pk_bf16(bflo(vr[2]) * w1[0], bfhi(vr[2]) * w1[1]); w.w = cvt_pk_bf16(bflo(vr[3]) * w1[2], bfhi(vr[3]) * w1[3]); Vw[t] = __builtin_bit_cast(bf16x8, w); }
#pragma unroll
            for (int m = 0; m < 8; ++m) { Cst[m] = Cst[m] * decay;
#pragma unroll
                for (int t = 0; t < 2; ++t) { const bf16x8 A = *(const LAS bf16x8*)(lds + ML_KT + (16 * m + fr) * ML_TROW + (32 * t + 8 * fq) * 2);
                    Cst[m] = __builtin_amdgcn_mfma_f32_16x16x32_bf16(A, Vw[t], Cst[m], 0, 0, 0); } }
            const int nk = tid >> 2, np = tid & 3; float s = 0.f;
#pragma unroll
            for (int i = 0; i < 2; ++i) { const u32x4 kw = *(const LAS u32x4*)(lds + ML_KT + nk * ML_TROW + np * 32 + i * 16);
                const f32x4 w0 = *(const LAS f32x4*)(lds + ML_GW + (16 * np + 8 * i) * 4), w1 = *(const LAS f32x4*)(lds + ML_GW + (16 * np + 8 * i + 4) * 4);
                s += bflo(kw[0]) * w0[0] + bfhi(kw[0]) * w0[1] + bflo(kw[1]) * w0[2] + bfhi(kw[1]) * w0[3];
                s += bflo(kw[2]) * w1[0] + bfhi(kw[2]) * w1[1] + bflo(kw[3]) * w1[2] + bfhi(kw[3]) * w1[3]; }
            s += __shfl_xor(s, 1); s += __shfl_xor(s, 2);
            if (np == 0) { LAS float* nn = (LAS float*)(lds + ML_N + nk * 4); *nn = decay * (*nn) + s; }
        }
        __syncthreads();
        {
            float xv[16];
#pragma unroll
            for (int i = 0; i < 4; ++i) { const f32x4 hv = *(const LAS f32x4*)(lds + ML_H + el * ML_HROW + (16 * ep + 4 * i) * 4);
                const unsigned ow0 = oraw[i >> 1][2 * (i & 1)], ow1 = oraw[i >> 1][2 * (i & 1) + 1];
                xv[4 * i + 0] = hv[0] * sigmoidf_(bflo(ow0)); xv[4 * i + 1] = hv[1] * sigmoidf_(bfhi(ow0)); xv[4 * i + 2] = hv[2] * sigmoidf_(bflo(ow1)); xv[4 * i + 3] = hv[3] * sigmoidf_(bfhi(ow1)); }
            float sm = 0.f;
#pragma unroll
            for (int i = 0; i < 16; ++i) sm += xv[i];
#pragma unroll
            for (int o = 1; o < 8; o <<= 1) sm += __shfl_xor(sm, o);
            const float mean = sm * (1.f / 128.f); float sq = 0.f;
#pragma unroll
            for (int i = 0; i < 16; ++i) { xv[i] -= mean; sq += xv[i] * xv[i]; }
#pragma unroll
            for (int o = 1; o < 8; o <<= 1) sq += __shfl_xor(sq, o);
            const float rstd = rsqrtf(sq * (1.f / 128.f) + EPS);
            unsigned ow[8];
#pragma unroll
            for (int i = 0; i < 4; ++i) { const f32x4 g = *(const f32x4*)(p.hn_g + h * 128 + 16 * ep + 4 * i);
                const unsigned zw0 = zraw[i >> 1][2 * (i & 1)], zw1 = zraw[i >> 1][2 * (i & 1) + 1];
                const float z0 = bflo(zw0), z1 = bfhi(zw0), z2 = bflo(zw1), z3 = bfhi(zw1);
                ow[2 * i] = cvt_pk_bf16(xv[4 * i] * rstd * g[0] * z0 * sigmoidf_(z0), xv[4 * i + 1] * rstd * g[1] * z1 * sigmoidf_(z1));
                ow[2 * i + 1] = cvt_pk_bf16(xv[4 * i + 2] * rstd * g[2] * z2 * sigmoidf_(z2), xv[4 * i + 3] * rstd * g[3] * z3 * sigmoidf_(z3)); }
            bf16_t* op = p.MIX + erow * DM + 512 + h * 128 + 16 * ep;
            *(u32x4*)op = (u32x4){ow[0], ow[1], ow[2], ow[3]}; *(u32x4*)(op + 8) = (u32x4){ow[4], ow[5], ow[6], ow[7]};
        }
    }
}

constexpr int M2_SET = 53248, M2_Q = 0, M2_K = 17408, M2_V = 34816, M2_G = 52224;
constexpr int M2_SB = 2 * M2_SET, M2_GW = M2_SB + 9216, M2_N = M2_GW + 256, M2_RDEN = M2_N + 512, M2_SCAN = M2_RDEN + 256;
constexpr int M2_ROW = 272, M2_SROW = 144;
constexpr int M2_H = M2_SCAN;

__device__ __forceinline__ void ml2_stage(LAS unsigned char* set, const u32x4 (&raw)[7], const u32x4 (&vraw)[2], float graw, const float (&cw)[4][8], const float (&cb)[8],
                                          int isK, int rg, int cg, int tid) {
    float o[4][8];
#pragma unroll
    for (int i = 0; i < 4; ++i)
#pragma unroll
        for (int e = 0; e < 8; ++e) o[i][e] = cb[e];
#pragma unroll
    for (int rr = 0; rr < 7; ++rr) {
        float in[8];
#pragma unroll
        for (int e = 0; e < 4; ++e) { in[2 * e] = bflo(raw[rr][e]); in[2 * e + 1] = bfhi(raw[rr][e]); }
#pragma unroll
        for (int i = 0; i < 4; ++i) { const int j = rr - i; if (j >= 0 && j < 4) {
#pragma unroll
            for (int e = 0; e < 8; ++e) o[i][e] += cw[j][e] * in[e]; } }
    }
    LAS unsigned char* nat = set + (isK ? M2_K : M2_Q);
#pragma unroll
    for (int i = 0; i < 4; ++i) { u32x4 w; w.x = cvt_pk_bf16(o[i][0], o[i][1]); w.y = cvt_pk_bf16(o[i][2], o[i][3]); w.z = cvt_pk_bf16(o[i][4], o[i][5]); w.w = cvt_pk_bf16(o[i][6], o[i][7]);
        *(LAS u32x4*)(nat + (4 * rg + i) * M2_ROW + cg * 16) = w; }
    LAS unsigned char* vp = set + M2_V + (tid >> 3) * M2_ROW + (tid & 7) * 32;
    *(LAS u32x4*)vp = vraw[0]; *(LAS u32x4*)(vp + 16) = vraw[1];
    if (tid < 256) *(LAS float*)(set + M2_G + tid * 4) = graw;
}

__device__ void ml_fast2(const Params& p, LAS unsigned char* lds, unsigned* bar_ctr, unsigned bar_target) {
    const int bh = blockIdx.x; if (bh >= 64) return;
    const int b = bh >> 2, h = bh & 3, tid = threadIdx.x, lane = tid & 63, wid = __builtin_amdgcn_readfirstlane(tid >> 6), fr = lane & 15, fq = lane >> 4;
    float* mlg = p.MLG + (size_t)bh * 4 * SEQ;
    {
        LAS float* scan = (LAS float*)(lds + M2_SCAN);
        float a_[8], pm_[8], bc_[8];
#pragma unroll
        for (int i = 0; i < 8; ++i) {
            const int c = wid + 8 * i; const size_t tok = (size_t)b * SEQ + 64 * c + lane;
            const float ig = p.G[tok * 8 + h], fg = p.G[tok * 8 + 4 + h];
            float bc = -softplus_acc(-fg);
#pragma unroll
            for (int o = 1; o < 64; o <<= 1) { const float t = __shfl_up(bc, o); if (lane >= o) bc += t; }
            const float a = ig - bc; float pm = a;
#pragma unroll
            for (int o = 1; o < 64; o <<= 1) { const float t = __shfl_up(pm, o); if (lane >= o) pm = fmaxf(pm, t); }
            a_[i] = a; pm_[i] = pm; bc_[i] = bc;
            if (lane == 63) { scan[c] = bc; scan[64 + c] = pm; }
        }
        __syncthreads();
        if (tid == 0) { float m = 0.f; for (int c = 0; c < 64; ++c) { scan[128 + c] = m; m = scan[c] + fmaxf(m, scan[64 + c]); } }
        __syncthreads();
#pragma unroll
        for (int i = 0; i < 8; ++i) {
            const int c = wid + 8 * i; const float mc = scan[128 + c]; const float M = fmaxf(mc, pm_[i]);
            const int o = 64 * c + lane;
            mlg[o] = a_[i]; mlg[SEQ + o] = M; mlg[2 * SEQ + o] = expf(mc - M); mlg[3 * SEQ + o] = expf(-(bc_[i] + M));
        }
        if (tid < 128) *(LAS float*)(lds + M2_N + tid * 4) = 0.f;
        __syncthreads();
    }
    grid_barrier(bar_ctr, bar_target);
    const int isK = tid >> 8, rg = (tid >> 4) & 15, cg = tid & 15;
    float cw[4][8], cb[8];
    {
        const int ch = isK * 512 + h * 128 + 8 * cg; const float sc = isK ? 0.08838834764831845f : 1.0f;
#pragma unroll
        for (int e = 0; e < 8; ++e) { cb[e] = p.conv_b[ch + e] * sc;
#pragma unroll
            for (int j = 0; j < 4; ++j) cw[j][e] = p.conv_w[j * 1024 + ch + e] * sc; }
    }
    const int el = tid >> 3, ep = tid & 7;
    const bf16_t* qkbase = p.P + (size_t)b * SEQ * NP + (isK ? 2560 : 2048) + h * 128 + 8 * cg;
    const bf16_t* vbase = p.P + (size_t)b * SEQ * NP + 3072 + h * 128 + (size_t)(tid >> 3) * NP + (tid & 7) * 16;
    f32x4 Cst[8];
#pragma unroll
    for (int m = 0; m < 8; ++m) Cst[m] = (f32x4){0.f, 0.f, 0.f, 0.f};
    f32x4 nacc = (f32x4){0.f, 0.f, 0.f, 0.f};
    u32x4 raw[7], vraw[2]; float graw = 0.f;
#pragma unroll
    for (int i = 0; i < 7; ++i) { const int r = 4 * rg - 3 + i; raw[i] = (r >= 0) ? *(const u32x4*)(qkbase + (size_t)r * NP) : (u32x4){0u, 0u, 0u, 0u}; }
    vraw[0] = *(const u32x4*)vbase; vraw[1] = *(const u32x4*)(vbase + 8);
    if (tid < 256) graw = mlg[(tid >> 6) * SEQ + (tid & 63)];
    ml2_stage(lds, raw, vraw, graw, cw, cb, isK, rg, cg, tid);
#pragma unroll
    for (int i = 0; i < 7; ++i) raw[i] = *(const u32x4*)(qkbase + (size_t)(64 + 4 * rg - 3 + i) * NP);
    vraw[0] = *(const u32x4*)(vbase + (size_t)64 * NP); vraw[1] = *(const u32x4*)(vbase + (size_t)64 * NP + 8);
    if (tid < 256) graw = mlg[(tid >> 6) * SEQ + 64 + (tid & 63)];

    for (int c = 0; c < 64; ++c) {
        LAS unsigned char* set = lds + (c & 1) * M2_SET;
        __syncthreads();
        if (c > 0) {
            const u32x4 h0 = *(const LAS u32x4*)(lds + M2_H + el * M2_ROW + ep * 32), h1 = *(const LAS u32x4*)(lds + M2_H + el * M2_ROW + ep * 32 + 16);
            bf16_t* hg = p.HRAW16 + ((size_t)b * SEQ + 64 * (c - 1) + el) * 512 + h * 128 + ep * 16;
            __builtin_nontemporal_store(h0, (u32x4*)hg); __builtin_nontemporal_store(h1, (u32x4*)(hg + 8)); }
        if (tid < 64) *(LAS float*)(lds + M2_GW + tid * 4) = __expf(*(LAS float*)(set + M2_G + tid * 4) - *(LAS float*)(set + M2_G + 256 + 63 * 4));
        {
            const int lt = wid >> 1;
#pragma unroll
            for (int si = 0; si < 2; ++si) {
                const int st = 2 * (wid & 1) + si;
                f32x4 acc = (f32x4){0.f, 0.f, 0.f, 0.f};
                float val[4] = {0.f, 0.f, 0.f, 0.f};
                if (st <= lt) {
#pragma unroll
                    for (int t = 0; t < 4; ++t) { const bf16x8 A = *(const LAS bf16x8*)(set + M2_Q + (16 * lt + fr) * M2_ROW + (32 * t + 8 * fq) * 2);
                        const bf16x8 B = *(const LAS bf16x8*)(set + M2_K + (16 * st + fr) * M2_ROW + (32 * t + 8 * fq) * 2);
                        acc = __builtin_amdgcn_mfma_f32_16x16x32_bf16(A, B, acc, 0, 0, 0); }
                    const float as = *(LAS float*)(set + M2_G + (16 * st + fr) * 4);
                    const f32x4 Ml = *(const LAS f32x4*)(set + M2_G + 256 + (16 * lt + 4 * fq) * 4);
#pragma unroll
                    for (int r = 0; r < 4; ++r) val[r] = (16 * st + fr <= 16 * lt + 4 * fq + r) ? acc[r] * __expf(as - Ml[r]) : 0.f;
                }
#pragma unroll
                for (int r = 0; r < 4; ++r) *(LAS bf16_t*)(lds + M2_SB + (16 * lt + 4 * fq + r) * M2_SROW + (16 * st + fr) * 2) = f2bf(val[r]);
            }
        }
        float qn = 0.f;
#pragma unroll
        for (int i = 0; i < 2; ++i) { const u32x4 qw = *(const LAS u32x4*)(set + M2_Q + el * M2_ROW + ep * 32 + i * 16);
            const f32x4 n0 = *(const LAS f32x4*)(lds + M2_N + (16 * ep + 8 * i) * 4), n1 = *(const LAS f32x4*)(lds + M2_N + (16 * ep + 8 * i + 4) * 4);
            qn += bflo(qw[0]) * n0[0] + bfhi(qw[0]) * n0[1] + bflo(qw[1]) * n0[2] + bfhi(qw[1]) * n0[3];
            qn += bflo(qw[2]) * n1[0] + bfhi(qw[2]) * n1[1] + bflo(qw[3]) * n1[2] + bfhi(qw[3]) * n1[3]; }
        __syncthreads();
        {
            const u32x4 sw = *(const LAS u32x4*)(lds + M2_SB + el * M2_SROW + ep * 16);
            float rs = 0.f;
#pragma unroll
            for (int e = 0; e < 4; ++e) rs += bflo(sw[e]) + bfhi(sw[e]);
            rs = sum8(rs); qn = sum8(qn);
            if (ep == 0) { const float den = *(LAS float*)(set + M2_G + 512 + el * 4) * qn + rs;
                *(LAS float*)(lds + M2_RDEN + el * 4) = 1.f / fmaxf(fabsf(den), *(LAS float*)(set + M2_G + 768 + el * 4)); }
        }
        if (c < 63) {
            ml2_stage(lds + ((c + 1) & 1) * M2_SET, raw, vraw, graw, cw, cb, isK, rg, cg, tid);
            if (c < 62) {
                const int r0 = 64 * (c + 2);
#pragma unroll
                for (int i = 0; i < 7; ++i) raw[i] = *(const u32x4*)(qkbase + (size_t)(r0 + 4 * rg - 3 + i) * NP);
                vraw[0] = *(const u32x4*)(vbase + (size_t)r0 * NP); vraw[1] = *(const u32x4*)(vbase + (size_t)r0 * NP + 8);
                if (tid < 256) graw = mlg[(tid >> 6) * SEQ + r0 + (tid & 63)];
            }
        }
        bf16x8 Vf[2];
#pragma unroll
        for (int t = 0; t < 2; ++t) { LAS unsigned char* va = set + M2_V + (32 * t + 8 * fq + (fr >> 2)) * M2_ROW + (16 * wid + 4 * (fr & 3)) * 2;
            const s16x4 lo = tr_read4(va), hi = tr_read4(va + 4 * M2_ROW); Vf[t] = __builtin_shufflevector(lo, hi, 0, 1, 2, 3, 4, 5, 6, 7); }
        f32x4 acc[4];
        {
            bf16x8 Cb[4];
#pragma unroll
            for (int t = 0; t < 4; ++t) { u32x4 w; w.x = cvt_pk_bf16(Cst[2 * t][0], Cst[2 * t][1]); w.y = cvt_pk_bf16(Cst[2 * t][2], Cst[2 * t][3]);
                w.z = cvt_pk_bf16(Cst[2 * t + 1][0], Cst[2 * t + 1][1]); w.w = cvt_pk_bf16(Cst[2 * t + 1][2], Cst[2 * t + 1][3]); Cb[t] = __builtin_bit_cast(bf16x8, w); }
#pragma unroll
            for (int mt = 0; mt < 4; ++mt) {
                acc[mt] = (f32x4){0.f, 0.f, 0.f, 0.f};
#pragma unroll
                for (int t = 0; t < 4; ++t) { LAS unsigned char* qa = set + M2_Q + (16 * mt + fr) * M2_ROW + (32 * t + 4 * fq) * 2;
                    const u32x2 lo = *(const LAS u32x2*)qa, hi = *(const LAS u32x2*)(qa + 32);
                    const bf16x8 A = __builtin_bit_cast(bf16x8, (u32x4){lo.x, lo.y, hi.x, hi.y});
                    acc[mt] = __builtin_amdgcn_mfma_f32_16x16x32_bf16(A, Cb[t], acc[mt], 0, 0, 0); }
                const f32x4 iw = *(const LAS f32x4*)(set + M2_G + 512 + (16 * mt + 4 * fq) * 4);
                acc[mt] = acc[mt] * iw;
#pragma unroll
                for (int t = 0; t < 2; ++t) { if (mt < 2 && t == 1) continue;
                    const bf16x8 A = *(const LAS bf16x8*)(lds + M2_SB + (16 * mt + fr) * M2_SROW + (32 * t + 8 * fq) * 2);
                    acc[mt] = __builtin_amdgcn_mfma_f32_16x16x32_bf16(A, Vf[t], acc[mt], 0, 0, 0); }
            }
        }
        __syncthreads();
        {
            LAS unsigned char* hp = lds + M2_H + (16 * wid + fr) * 2;
#pragma unroll
            for (int mt = 0; mt < 4; ++mt) { const f32x4 rd = *(const LAS f32x4*)(lds + M2_RDEN + (16 * mt + 4 * fq) * 4);
#pragma unroll
                for (int r = 0; r < 4; ++r) *(LAS bf16_t*)(hp + (16 * mt + 4 * fq + r) * M2_ROW) = f2bf(acc[mt][r] * rd[r]); }
        }
        {
            const float decay = *(LAS float*)(set + M2_G + 512 + 63 * 4);
            bf16x8 Vw[2], Wf[2];
#pragma unroll
            for (int t = 0; t < 2; ++t) { const u32x4 vr = __builtin_bit_cast(u32x4, Vf[t]);
                const f32x4 w0 = *(const LAS f32x4*)(lds + M2_GW + (32 * t + 8 * fq) * 4), w1 = *(const LAS f32x4*)(lds + M2_GW + (32 * t + 8 * fq + 4) * 4);
                u32x4 w; w.x = cvt_pk_bf16(bflo(vr[0]) * w0[0], bfhi(vr[0]) * w0[1]); w.y = cvt_pk_bf16(bflo(vr[1]) * w0[2], bfhi(vr[1]) * w0[3]);
                w.z = cvt_pk_bf16(bflo(vr[2]) * w1[0], bfhi(vr[2]) * w1[1]); w.w = cvt_pk_bf16(bflo(vr[3]) * w1[2], bfhi(vr[3]) * w1[3]); Vw[t] = __builtin_bit_cast(bf16x8, w);
                u32x4 ww; ww.x = cvt_pk_bf16(w0[0], w0[1]); ww.y = cvt_pk_bf16(w0[2], w0[3]); ww.z = cvt_pk_bf16(w1[0], w1[1]); ww.w = cvt_pk_bf16(w1[2], w1[3]);
                if (fr != 0) ww = (u32x4){0u, 0u, 0u, 0u};
                Wf[t] = __builtin_bit_cast(bf16x8, ww); }
            nacc = nacc * decay;
#pragma unroll
            for (int m = 0; m < 8; ++m) { Cst[m] = Cst[m] * decay;
#pragma unroll
                for (int t = 0; t < 2; ++t) { LAS unsigned char* ka = set + M2_K + (32 * t + 8 * fq + (fr >> 2)) * M2_ROW + (16 * m + 4 * (fr & 3)) * 2;
                    const s16x4 lo = tr_read4(ka), hi = tr_read4(ka + 4 * M2_ROW);
                    const bf16x8 A = __builtin_shufflevector(lo, hi, 0, 1, 2, 3, 4, 5, 6, 7);
                    Cst[m] = __builtin_amdgcn_mfma_f32_16x16x32_bf16(A, Vw[t], Cst[m], 0, 0, 0);
                    if (m == wid) nacc = __builtin_amdgcn_mfma_f32_16x16x32_bf16(A, Wf[t], nacc, 0, 0, 0); } }
            if (fr == 0) *(LAS f32x4*)(lds + M2_N + (16 * wid + 4 * fq) * 4) = nacc;
        }
    }
    __syncthreads();
    {   const u32x4 h0 = *(const LAS u32x4*)(lds + M2_H + el * M2_ROW + ep * 32), h1 = *(const LAS u32x4*)(lds + M2_H + el * M2_ROW + ep * 32 + 16);
        bf16_t* hg = p.HRAW16 + ((size_t)b * SEQ + 64 * 63 + el) * 512 + h * 128 + ep * 16;
        __builtin_nontemporal_store(h0, (u32x4*)hg); __builtin_nontemporal_store(h1, (u32x4*)(hg + 8)); }
}

__device__ __forceinline__ void ml_post(const Params& p) {
    const int tid = threadIdx.x, lane = tid & 63, wid = tid >> 6;
    const int gw = blockIdx.x * 256 + wid * 32, NGW = 1;
    const int c0 = (lane >> 4) * 128 + 8 * (lane & 15);
    float g[8];
#pragma unroll
    for (int i = 0; i < 8; ++i) g[i] = p.hn_g[c0 + i];
    for (int row0 = gw; row0 < gw + 32; row0 += 4 * NGW) {
        u32x4 hv4[4], ov4[4], zv4[4];
#pragma unroll
        for (int q = 0; q < 4; ++q) { const size_t row = (size_t)row0 + (size_t)q * NGW;
            hv4[q] = __builtin_nontemporal_load((const u32x4*)(p.HRAW16 + row * 512 + c0)); ov4[q] = __builtin_nontemporal_load((const u32x4*)(p.P + row * NP + 3584 + c0)); zv4[q] = __builtin_nontemporal_load((const u32x4*)(p.P + row * NP + 4096 + c0)); }
#pragma unroll
        for (int q = 0; q < 4; ++q) {
            const size_t row = (size_t)row0 + (size_t)q * NGW; const u32x4 hv = hv4[q], ov = ov4[q], zv = zv4[q];
            float x[8]; float sm = 0.f;
#pragma unroll
            for (int e = 0; e < 4; ++e) { x[2 * e] = bflo(hv[e]) * sigmoidf_(bflo(ov[e])); x[2 * e + 1] = bfhi(hv[e]) * sigmoidf_(bfhi(ov[e])); sm += x[2 * e] + x[2 * e + 1]; }
            sm = sum16(sm);
            const float mean = sm * (1.f / 128.f); float sq = 0.f;
#pragma unroll
            for (int i = 0; i < 8; ++i) { x[i] -= mean; sq += x[i] * x[i]; }
            sq = sum16(sq);
            const float rstd = rsqrtf(sq * (1.f / 128.f) + EPS);
            u32x4 ow;
#pragma unroll
            for (int e = 0; e < 4; ++e) { const float z0 = bflo(zv[e]), z1 = bfhi(zv[e]);
                ow[e] = cvt_pk_bf16(x[2 * e] * rstd * g[2 * e] * z0 * sigmoidf_(z0), x[2 * e + 1] * rstd * g[2 * e + 1] * z1 * sigmoidf_(z1)); }
            *(u32x4*)(p.MIX + row * DM + 512 + c0) = ow;
        }
    }
}

__device__ __forceinline__ void phase_final(const Params& p) {
    const int tid = threadIdx.x, lane = tid & 63, wid = tid >> 6;
    const int base = blockIdx.x * 256 + wid * 32;
    f32x4 g[4];
#pragma unroll
    for (int j = 0; j < 4; ++j) g[j] = *(const f32x4*)(p.fin_g + 4 * lane + 256 * j);
    f32x4 v[2][4], vn[2][4]; u32x2 d[2][4], dn[2][4];
#pragma unroll
    for (int q = 0; q < 2; ++q)
#pragma unroll
        for (int j = 0; j < 4; ++j) { const size_t r = (size_t)base + q; v[q][j] = __builtin_nontemporal_load((const f32x4*)(p.x + r * DM + 4 * lane + 256 * j)); d[q][j] = __builtin_nontemporal_load((const u32x2*)(p.U + r * DM + 4 * lane + 256 * j)); }
    for (int it = 0; it < 16; ++it) {
        const int row0 = base + 2 * it;
        if (it < 15) {
#pragma unroll
            for (int q = 0; q < 2; ++q)
#pragma unroll
                for (int j = 0; j < 4; ++j) { const size_t r = (size_t)row0 + 2 + q; vn[q][j] = __builtin_nontemporal_load((const f32x4*)(p.x + r * DM + 4 * lane + 256 * j)); dn[q][j] = __builtin_nontemporal_load((const u32x2*)(p.U + r * DM + 4 * lane + 256 * j)); }
        }
#pragma unroll
        for (int q = 0; q < 2; ++q) {
            const size_t row = (size_t)row0 + q;
            float ss = 0.f;
#pragma unroll
            for (int j = 0; j < 4; ++j) { v[q][j][0] += bflo(d[q][j].x); v[q][j][1] += bfhi(d[q][j].x); v[q][j][2] += bflo(d[q][j].y); v[q][j][3] += bfhi(d[q][j].y);
                ss += (v[q][j][0] * v[q][j][0] + v[q][j][1] * v[q][j][1]) + (v[q][j][2] * v[q][j][2] + v[q][j][3] * v[q][j][3]); }
            ss = wave_sum(ss);
            const float rstd = rsqrtf(ss * (1.f / DM) + EPS);
#pragma unroll
            for (int j = 0; j < 4; ++j) __builtin_nontemporal_store(v[q][j] * rstd * g[j], (f32x4*)(p.out + row * DM + 4 * lane + 256 * j));
        }
#pragma unroll
        for (int q = 0; q < 2; ++q)
#pragma unroll
            for (int j = 0; j < 4; ++j) { v[q][j] = vn[q][j]; d[q][j] = dn[q][j]; }
    }
}

#ifndef PROBE_SEL
#define PROBE_SEL 0
#endif
#define STAMP(i) do { if (PROBE_SEL && threadIdx.x == 0 && (blockIdx.x == 0 || blockIdx.x == 64)) p.TS[(blockIdx.x ? 32 : 0) + (i)] = __builtin_amdgcn_s_memrealtime(); } while (0)
__global__ void __launch_bounds__(512, 2) hymba_fwd(Params p) {
    extern __shared__ __attribute__((aligned(16))) unsigned char smem[];
    LAS unsigned char* lds = (LAS unsigned char*)smem;
    cg::grid_group grid = cg::this_grid();
    STAMP(0);
    if (p.never) grid.sync();
    phase_prep(p, lds);
    STAMP(1);
    grid_barrier(p.BAR, gridDim.x * 1u);
    STAMP(2);
    {
        pg8::Gemm g{p.U, p.WIT, NTOK, NP, DM}; pg8::StaticOrder S; S.init(NTOK, 6 * 256, gridDim.x, blockIdx.x); S.cols(8, 1 << 30, 0);
        pg8::EpiBf16T<true> E{p.P, NP};
        pg8::gemm_phase(lds, g, S, E);
    }
    STAMP(3);
    if (blockIdx.x < 64) {
    STAMP(4);
        ml_fast2(p, lds, p.BAR + 8, gridDim.x);
        grid_wait(p.BAR + 16, gridDim.x - 64u);
    } else {
        grid_arrive(p.BAR + 8);
        {
            pg8::Gemm g{p.U, p.WIT, NTOK, NP, DM}; pg8::StaticOrder S; S.init(NTOK, 12 * 256, (int)gridDim.x - 64, (int)blockIdx.x - 64); S.cols(0, 8, 6);
            pg8::EpiBf16T<true> E{p.P, NP};
            pg8::gemm_phase(lds, g, S, E);
        }
        grid_barrier(p.BAR + 16, gridDim.x - 64u);
    }
    att_fast(p, lds, 0, (int)gridDim.x);
    STAMP(5);
    grid_barrier(p.BAR, gridDim.x * 2u);
    ml_post(p);
    asm volatile("s_waitcnt vmcnt(0)" ::: "memory");
    __syncthreads();
    STAMP(6);
    {
        pg8::Gemm g{p.MIX, p.WOT, NTOK, DM, DM}; pg8::PanelOrder S{(int)blockIdx.x};
        pg8::EpiBf16T<false> E{p.U, DM};
        pg8::gemm_phase(lds, g, S, E);
    }
    STAMP(7);
    asm volatile("s_waitcnt vmcnt(0)" ::: "memory");
    __syncthreads();
    STAMP(8);
    phase_final(p);
    STAMP(9);
#if PROBE_SEL
    grid_barrier(p.BAR, gridDim.x * 3u);
    if (blockIdx.x == 0 && threadIdx.x == 0) {
        const unsigned long long* a = p.TS; const unsigned long long* c = p.TS + 32;
        unsigned long long d = 0;
        if (PROBE_SEL == 1) d = c[1] - c[0];
        if (PROBE_SEL == 2) d = c[3] - c[2];
        if (PROBE_SEL == 3) d = c[5] - c[4];
        if (PROBE_SEL == 4) d = a[5] - a[4];
        if (PROBE_SEL == 5) d = c[7] - c[6];
        if (PROBE_SEL == 6) d = c[9] - c[8];
        if (PROBE_SEL == 7) d = (c[2] - c[1]) + (c[4] - c[3]) + (c[6] - c[5]) + (c[8] - c[7]);
        d *= 4;
        const unsigned long long t0 = __builtin_amdgcn_s_memrealtime();
        while (__builtin_amdgcn_s_memrealtime() - t0 < d) __builtin_amdgcn_s_sleep(8);
    }
#endif
}

extern "C" void kernel_launch(void* const* d_in, const int* in_sizes, int n_in, void* d_out, int out_size, void* d_ws, size_t ws_size, hipStream_t stream) {
    static int grid_blocks = 0;
    if (!grid_blocks) {
        int dev = 0, cus = 0, per_cu = 0;
        (void)hipGetDevice(&dev);
        (void)hipDeviceGetAttribute(&cus, hipDeviceAttributeMultiprocessorCount, dev);
        (void)hipFuncSetAttribute((const void*)hymba_fwd, hipFuncAttributeMaxDynamicSharedMemorySize, LDS_BYTES);
        (void)hipOccupancyMaxActiveBlocksPerMultiprocessor(&per_cu, (const void*)hymba_fwd, 512, LDS_BYTES);
        (void)hipGetLastError();
        if (per_cu < 1) per_cu = 1;
        grid_blocks = cus;
        if (grid_blocks > 256) grid_blocks = 256;
    }
    Params p{};
    p.x = (const float*)d_in[0]; p.norm_g = (const float*)d_in[1]; p.w_in = (const float*)d_in[2]; p.b_ig = (const float*)d_in[3]; p.b_fg = (const float*)d_in[4];
    p.conv_w = (const float*)d_in[5]; p.conv_b = (const float*)d_in[6]; p.hn_g = (const float*)d_in[7]; p.w_out = (const float*)d_in[8]; p.fin_g = (const float*)d_in[9];
    p.out = (float*)d_out;
    unsigned char* ws = (unsigned char*)d_ws; size_t off = 0;
    p.U = (bf16_t*)(ws + off); p.HRAW = (float*)(ws + off); off += (size_t)NTOK * DM * 2;
    p.P = (bf16_t*)(ws + off); off += (size_t)NTOK * NP * 2;
    p.MIX = (bf16_t*)(ws + off); off += (size_t)NTOK * DM * 2;
    p.WIT = (bf16_t*)(ws + off); off += (size_t)NP * DM * 2;
    p.WOT = (bf16_t*)(ws + off); off += (size_t)DM * DM * 2;
    p.G = (float*)(ws + off); off += (size_t)NTOK * 8 * 4;
    p.MLG = (float*)(ws + off); off += (size_t)64 * 4 * SEQ * 4;
    p.ROWSS = (float*)(ws + off); off += (size_t)NTOK * 4;
    p.TS = (unsigned long long*)(ws + off); off += 4096;
    p.BAR = (unsigned*)(ws + off); off += 256;
    p.HRAW16 = (bf16_t*)(ws + off); off += (size_t)NTOK * 512 * 2;
    p.never = 0;
    if (off > ws_size) { fprintf(stderr, "workspace too small: need %zu have %zu\n", off, ws_size); return; }
    (void)hipMemsetAsync(p.BAR, 0, 256, stream);
    void* args[] = {&p};
    hipError_t e = hipLaunchCooperativeKernel((const void*)hymba_fwd, dim3(grid_blocks), dim3(512), args, LDS_BYTES, stream);
    if (e != hipSuccess) fprintf(stderr, "cooperative launch failed: %s (grid %d)\n", hipGetErrorString(e), grid_blocks);
}
```
